# Optimizing an MI355X kernel written in HIP

```python
import math
import jax, jax.numpy as jnp
from jax import lax
import numpy as np

D_MODEL = 1024
BATCH = 8
SEQ = 8192
DEPTH = 2
DEC_BATCH = 16
DEC_SEQ = 32
PAST_LEN = 4096

F32 = jnp.float32
CHUNK = 64
Q_BLOCK = 128
D_MIX = D_MODEL
MLA_HEADS = 6
NOPE_DIM = 64
ROPE_DIM = 32
V_DIM = 64
Q_RANK = 256
KV_RANK = 128
ROPE_BASE = 10000.0
MLA_W = MLA_HEADS * V_DIM
MLA_SCALE = (NOPE_DIM + ROPE_DIM) ** -0.5
MLA_PROJ = Q_RANK + KV_RANK + ROPE_DIM
S5_GROUP_CH = 16
S5_W = 256
S5_GROUPS = S5_W // S5_GROUP_CH
S5_STATE = 64
RWKV_HEADS = 6
RWKV_HEAD = 64
RWKV_W = RWKV_HEADS * RWKV_HEAD
DECAY_LORA = 32
AAA_LORA = 32
GATE_LORA = 64
RWKV_PROJ = 3 * RWKV_W + DECAY_LORA + AAA_LORA + GATE_LORA
RWKV_SPLITS = (RWKV_W, 2 * RWKV_W, 3 * RWKV_W, 3 * RWKV_W + DECAY_LORA, 3 * RWKV_W + DECAY_LORA + AAA_LORA)
N_IN = MLA_PROJ + S5_W + RWKV_PROJ
IN_SPLITS = (Q_RANK, Q_RANK + KV_RANK, MLA_PROJ, MLA_PROJ + S5_W)
D_FF = 4 * D_MODEL
ALPHA = (2 * DEPTH) ** 0.25
BETA = (8 * DEPTH) ** -0.25
LN_EPS = 1e-5
RMS_EPS = 1e-6
GN_EPS = 64e-5
NEG_INF = -1e30

kernel_name = 'hybrid_mla_s5_rwkv7_streaming_step'


def layer_norm(x, g, b):
    xf = x.astype(F32)
    mu = jnp.mean(xf, -1, keepdims=True)
    var = jnp.mean(jnp.square(xf - mu), -1, keepdims=True)
    return ((xf - mu) * lax.rsqrt(var + LN_EPS) * g.astype(F32) + b.astype(F32)).astype(x.dtype)


def rms_norm(x, g):
    xf = x.astype(F32)
    inv = lax.rsqrt(jnp.mean(jnp.square(xf), -1, keepdims=True) + RMS_EPS)
    return (xf * inv * g.astype(F32)).astype(x.dtype)


def rope_tables(pos):
    inv_freq = ROPE_BASE ** (-jnp.arange(0, ROPE_DIM, 2, dtype=F32) / ROPE_DIM)
    ang = pos.astype(F32)[:, None] * inv_freq[None, :]
    ang = jnp.concatenate([ang, ang], -1)
    return jnp.cos(ang), jnp.sin(ang)


def apply_rope(x, cos, sin):
    shape = (1, cos.shape[0]) + (1,) * (x.ndim - 3) + (ROPE_DIM,)
    c, s = cos.reshape(shape), sin.reshape(shape)
    xf = x.astype(F32)
    x1, x2 = jnp.split(xf, 2, axis=-1)
    return (xf * c + jnp.concatenate([-x2, x1], -1) * s).astype(x.dtype)


def mla_scores(q_nope, q_rope, k_nope, k_rope):
    s = jnp.einsum('bqhd,bkhd->bhqk', q_nope, k_nope) + jnp.einsum('bqhr,bkr->bhqk', q_rope, k_rope)
    return s.astype(F32) * MLA_SCALE


def attend(s, v, mask=None):
    if mask is not None:
        s = jnp.where(mask, s, NEG_INF)
    p = jax.nn.softmax(s, axis=-1).astype(v.dtype)
    return jnp.einsum('bhqk,bkhd->bqhd', p, v)


def mla_prompt_attention(q_nope, q_rope, k_nope, k_rope, v):
    b, s = q_nope.shape[:2]
    key_chunk = jnp.arange(s) // CHUNK

    def query_block(i):
        start = i * Q_BLOCK
        qn = lax.dynamic_slice_in_dim(q_nope, start, Q_BLOCK, axis=1)
        qr = lax.dynamic_slice_in_dim(q_rope, start, Q_BLOCK, axis=1)
        q_chunk = (start + jnp.arange(Q_BLOCK)) // CHUNK
        mask = key_chunk[None, :] <= q_chunk[:, None]
        return attend(mla_scores(qn, qr, k_nope, k_rope), v, mask)

    out = lax.map(query_block, jnp.arange(s // Q_BLOCK))
    return jnp.swapaxes(out, 0, 1).reshape(b, s, MLA_W)


def mla_mixer(q_lat, kv_lat, k_rope_raw, pos, ckv_past, krope_past, prm):
    b, t = q_lat.shape[:2]
    cos, sin = rope_tables(pos)
    q = (rms_norm(q_lat, prm['q_norm_g']) @ prm['w_qb']).reshape(b, t, MLA_HEADS, NOPE_DIM + ROPE_DIM)
    q_nope = q[..., :NOPE_DIM]
    q_rope = apply_rope(q[..., NOPE_DIM:], cos, sin)
    ckv = rms_norm(kv_lat, prm['kv_norm_g'])
    krope = apply_rope(k_rope_raw, cos, sin)
    if ckv_past is None:
        ckv_all, krope_all = ckv, krope
    else:
        ckv_all = jnp.concatenate([ckv_past.astype(ckv.dtype), ckv], 1)
        krope_all = jnp.concatenate([krope_past.astype(krope.dtype), krope], 1)
    kv = (ckv_all @ prm['w_kvb']).reshape(b, ckv_all.shape[1], MLA_HEADS, NOPE_DIM + V_DIM)
    k_nope, v = kv[..., :NOPE_DIM], kv[..., NOPE_DIM:]
    if ckv_past is None:
        out = mla_prompt_attention(q_nope, q_rope, k_nope, krope_all, v)
    else:
        out = attend(mla_scores(q_nope, q_rope, k_nope, krope_all), v).reshape(b, t, MLA_W)
    return out, ckv, krope


def s5_discretize(prm):
    lam = lax.complex(prm['lam_re'].astype(F32), prm['lam_im'].astype(F32))
    dt = jnp.exp(prm['log_dt'].astype(F32))[:, None]
    lam_bar = jnp.exp(lam * dt)
    b = lax.complex(prm['b_re'].astype(F32), prm['b_im'].astype(F32))
    b_bar = ((lam_bar - 1.0) / lam)[..., None] * b
    c = lax.complex(prm['c_re'].astype(F32), prm['c_im'].astype(F32))
    return lam_bar, b_bar, c


def _linear_recurrence_combine(e1, e2):
    a1, b1 = e1
    a2, b2 = e2
    return a1 * a2, a2 * b1 + b2


def s5_block(u_blk, x0, lam_bar, b_bar, c):
    bu = jnp.einsum('gpc,btgc->btgp', b_bar, u_blk.astype(jnp.complex64))
    a = jnp.broadcast_to(lam_bar, bu.shape)
    a_cum, xs = lax.associative_scan(_linear_recurrence_combine, (a, bu), axis=1)
    xs = xs + a_cum * x0[:, None]
    y = jnp.einsum('gcp,btgp->btgc', c, xs).real
    return y, xs[:, -1]


def s5_mixer(u, x0, block_len, prm):
    b, t = u.shape[:2]
    lam_bar, b_bar, c = s5_discretize(prm)
    uf = u.astype(F32)
    ub = jnp.swapaxes(uf.reshape(b, t // block_len, block_len, S5_GROUPS, S5_GROUP_CH), 0, 1)

    def step(state, u_blk):
        y, state = s5_block(u_blk, state, lam_bar, b_bar, c)
        return state, y

    x_last, ys = lax.scan(step, x0, ub)
    y = jnp.swapaxes(ys, 0, 1).reshape(b, t, S5_W) + prm['s5_d'].astype(F32) * uf
    z = jax.nn.gelu(y)
    out = z * jax.nn.sigmoid(z @ prm['w_glu'].astype(F32) + prm['b_glu'].astype(F32))
    return out.astype(u.dtype), jnp.stack([x_last.real, x_last.imag], -1)


def rwkv_scan(r, w, k, v, kk, a, s0):
    xs = tuple(jnp.moveaxis(z.astype(F32), 1, 0) for z in (r, w, k, v, kk, a))

    def step(S, inp):
        r_t, w_t, k_t, v_t, kk_t, a_t = inp
        sa = jnp.einsum('bhij,bhj->bhi', S, -kk_t)
        S = (S * w_t[:, :, None, :] + sa[..., None] * (kk_t * a_t)[:, :, None, :]
             + v_t[..., None] * k_t[:, :, None, :])
        return S, jnp.einsum('bhij,bhj->bhi', S, r_t)

    s_last, ys = lax.scan(step, s0.astype(F32), xs)
    return jnp.moveaxis(ys, 0, 1), s_last


def rwkv_mixer(p, shift0, s0, prm):
    b, t = p.shape[:2]
    heads = (RWKV_HEADS, RWKV_HEAD)
    prev = jnp.concatenate([shift0.astype(p.dtype), p[:, :-1]], 1)
    ps = (p + (prev - p) * prm['mu_shift']).astype(F32)
    r, k, v, wd, ad, gd = jnp.split(ps, RWKV_SPLITS, axis=-1)
    w_log = -jax.nn.softplus(-(prm['w0'] + jnp.tanh(wd) @ prm['w_w2'])) - 0.5
    decay = jnp.exp(-jnp.exp(w_log))
    a = jax.nn.sigmoid(prm['a0'] + ad @ prm['w_a2'])
    g = jax.nn.sigmoid(gd) @ prm['w_g2']
    hs = lambda z: z.reshape(b, t, RWKV_HEADS, RWKV_HEAD)
    r, k, v, decay, a = hs(r), hs(k), hs(v), hs(decay), hs(a)
    kk = k * prm['k_k'].reshape(heads)
    kk = kk / jnp.maximum(jnp.linalg.norm(kk, axis=-1, keepdims=True), 1e-12)
    k = k * (1.0 + (a - 1.0) * prm['k_a'].reshape(heads))
    y, s_last = rwkv_scan(r, decay, k, v, kk, a, s0)
    mu = jnp.mean(y, -1, keepdims=True)
    var = jnp.mean(jnp.square(y - mu), -1, keepdims=True)
    y = ((y - mu) * lax.rsqrt(var + GN_EPS)).reshape(b, t, RWKV_W) * prm['gn_g'] + prm['gn_b']
    bonus = jnp.sum(r * k * prm['r_k'], -1, keepdims=True) * v
    y = (y + bonus.reshape(b, t, RWKV_W)) * g
    return y.astype(p.dtype), s_last, p[:, -1:]


def trunk_layer(x, pos, ckv_past, krope_past, s5_x0, rwkv_s0, shift0, s5_block_len, prm):
    proj = x @ prm['w_in']
    q_lat, kv_lat, k_rope_raw, u, p_rwkv = jnp.split(proj, IN_SPLITS, axis=-1)
    mla_out, ckv, krope = mla_mixer(q_lat, kv_lat, k_rope_raw, pos, ckv_past, krope_past, prm)
    s5_out, s5_state = s5_mixer(u, s5_x0, s5_block_len, prm)
    rwkv_out, rwkv_state, shift = rwkv_mixer(p_rwkv, shift0, rwkv_s0, prm)
    merged = jnp.concatenate([mla_out.astype(x.dtype), s5_out.astype(x.dtype), rwkv_out.astype(x.dtype)], -1)
    x = layer_norm(ALPHA * x + merged @ prm['w_out'], prm['ln1_g'], prm['ln1_b'])
    hidden = jnp.square(jax.nn.relu(x @ prm['w_up']))
    x = layer_norm(ALPHA * x + hidden @ prm['w_down'], prm['ln2_g'], prm['ln2_b'])
    return x, ckv, krope, s5_state, rwkv_state, shift


def setup_inputs(seed: int = 0) -> dict:
    key = jax.random.key(seed)
    ks = iter(jax.random.split(key, 64))

    def nrm(shape, scale):
        return scale * jax.random.normal(next(ks), shape, F32)

    def unif(shape, lo, hi):
        return jax.random.uniform(next(ks), shape, F32, lo, hi)

    L = DEPTH
    G, P, GC = S5_GROUPS, S5_STATE, S5_GROUP_CH
    H, N = RWKV_HEADS, RWKV_HEAD
    return {
        'x_prompt': nrm((BATCH, SEQ, D_MODEL), 1.0),
        'x_sample': nrm((DEC_BATCH, DEC_SEQ, D_MODEL), 1.0),
        'cache_mla_ckv': nrm((L, DEC_BATCH, PAST_LEN, KV_RANK), 1.0),
        'cache_mla_krope': nrm((L, DEC_BATCH, PAST_LEN, ROPE_DIM), 1.0),
        'state_s5': nrm((L, DEC_BATCH, G, P, 2), 0.1),
        'state_rwkv': nrm((L, DEC_BATCH, H, N, N), 0.3),
        'state_rwkv_shift': nrm((L, DEC_BATCH, 1, RWKV_PROJ), 1.0),
        'w_in': nrm((L, D_MODEL, N_IN), D_MODEL ** -0.5),
        'q_norm_g': 1.0 + nrm((L, Q_RANK), 0.02),
        'w_qb': nrm((L, Q_RANK, MLA_HEADS * (NOPE_DIM + ROPE_DIM)), Q_RANK ** -0.5),
        'kv_norm_g': 1.0 + nrm((L, KV_RANK), 0.02),
        'w_kvb': nrm((L, KV_RANK, MLA_HEADS * (NOPE_DIM + V_DIM)), KV_RANK ** -0.5),
        'lam_re': -0.5 + nrm((L, G, P), 0.01),
        'lam_im': math.pi * jnp.arange(P, dtype=F32) + nrm((L, G, P), 0.01),
        'log_dt': unif((L, G), math.log(1e-3), math.log(1e-1)),
        'b_re': nrm((L, G, P, GC), (0.5 / GC) ** 0.5),
        'b_im': nrm((L, G, P, GC), (0.5 / GC) ** 0.5),
        'c_re': nrm((L, G, GC, P), P ** -0.5),
        'c_im': nrm((L, G, GC, P), P ** -0.5),
        's5_d': nrm((L, S5_W), 1.0),
        'w_glu': nrm((L, S5_W, S5_W), S5_W ** -0.5),
        'b_glu': nrm((L, S5_W), 0.02),
        'mu_shift': unif((L, RWKV_PROJ), 0.0, 1.0),
        'w0': unif((L, RWKV_W), -6.0, 1.0),
        'w_w2': nrm((L, DECAY_LORA, RWKV_W), 0.1 * DECAY_LORA ** -0.5),
        'a0': nrm((L, RWKV_W), 0.5),
        'w_a2': nrm((L, AAA_LORA, RWKV_W), 0.1 * AAA_LORA ** -0.5),
        'w_g2': nrm((L, GATE_LORA, RWKV_W), GATE_LORA ** -0.5),
        'k_k': 0.85 + nrm((L, RWKV_W), 0.05),
        'k_a': 1.0 + nrm((L, RWKV_W), 0.05),
        'r_k': nrm((L, H, N), 0.1),
        'gn_g': 1.0 + nrm((L, RWKV_W), 0.02),
        'gn_b': nrm((L, RWKV_W), 0.02),
        'w_out': nrm((L, D_MIX, D_MODEL), BETA * D_MIX ** -0.5),
        'ln1_g': 1.0 + nrm((L, D_MODEL), 0.02),
        'ln1_b': nrm((L, D_MODEL), 0.02),
        'w_up': nrm((L, D_MODEL, D_FF), D_MODEL ** -0.5),
        'w_down': nrm((L, D_FF, D_MODEL), BETA * D_FF ** -0.5),
        'ln2_g': 1.0 + nrm((L, D_MODEL), 0.02),
        'ln2_b': nrm((L, D_MODEL), 0.02),
    }


def reference(x_prompt, x_sample, cache_mla_ckv, cache_mla_krope, state_s5, state_rwkv, state_rwkv_shift,
              w_in, q_norm_g, w_qb, kv_norm_g, w_kvb, lam_re, lam_im, log_dt, b_re, b_im, c_re, c_im,
              s5_d, w_glu, b_glu, mu_shift, w0, w_w2, a0, w_a2, w_g2, k_k, k_a, r_k, gn_g, gn_b,
              w_out, ln1_g, ln1_b, w_up, w_down, ln2_g, ln2_b):
    bp, sp = x_prompt.shape[:2]
    ts = x_sample.shape[1]
    past = cache_mla_ckv.shape[2]
    pos_p = jnp.arange(sp)
    pos_s = past + jnp.arange(ts)
    s5_zero = jnp.zeros((bp, S5_GROUPS, S5_STATE), jnp.complex64)
    rwkv_zero = jnp.zeros((bp, RWKV_HEADS, RWKV_HEAD, RWKV_HEAD), F32)
    shift_zero = jnp.zeros((bp, 1, RWKV_PROJ), x_prompt.dtype)

    xp, xs = x_prompt, x_sample
    ckv_p, krope_p, s5_p, rwkv_p, shift_p = [], [], [], [], []
    ckv_s, krope_s, s5_s, rwkv_s, shift_s = [], [], [], [], []
    for l in range(DEPTH):
        prm = dict(w_in=w_in[l], q_norm_g=q_norm_g[l], w_qb=w_qb[l], kv_norm_g=kv_norm_g[l], w_kvb=w_kvb[l],
                   lam_re=lam_re[l], lam_im=lam_im[l], log_dt=log_dt[l], b_re=b_re[l], b_im=b_im[l],
                   c_re=c_re[l], c_im=c_im[l], s5_d=s5_d[l], w_glu=w_glu[l], b_glu=b_glu[l],
                   mu_shift=mu_shift[l], w0=w0[l], w_w2=w_w2[l], a0=a0[l], w_a2=w_a2[l], w_g2=w_g2[l],
                   k_k=k_k[l], k_a=k_a[l], r_k=r_k[l], gn_g=gn_g[l], gn_b=gn_b[l], w_out=w_out[l],
                   ln1_g=ln1_g[l], ln1_b=ln1_b[l], w_up=w_up[l], w_down=w_down[l], ln2_g=ln2_g[l], ln2_b=ln2_b[l])
        xp, c1, k1, s1, r1, h1 = trunk_layer(xp, pos_p, None, None, s5_zero, rwkv_zero, shift_zero, CHUNK, prm)
        ckv_p.append(c1); krope_p.append(k1); s5_p.append(s1); rwkv_p.append(r1); shift_p.append(h1)
        s5_x0 = lax.complex(state_s5[l, ..., 0].astype(F32), state_s5[l, ..., 1].astype(F32))
        xs, c2, k2, s2, r2, h2 = trunk_layer(xs, pos_s, cache_mla_ckv[l], cache_mla_krope[l], s5_x0,
                                             state_rwkv[l], state_rwkv_shift[l], ts, prm)
        ckv_s.append(c2); krope_s.append(k2); s5_s.append(s2); rwkv_s.append(r2); shift_s.append(h2)

    return (xp, xs,
            jnp.stack(ckv_p), jnp.stack(krope_p), jnp.stack(s5_p), jnp.stack(rwkv_p), jnp.stack(shift_p),
            jnp.stack(ckv_s), jnp.stack(krope_s), jnp.stack(s5_s), jnp.stack(rwkv_s), jnp.stack(shift_s))
```

```cpp
#include <hip/hip_runtime.h>
#include <hip/hip_cooperative_groups.h>
#include <stdint.h>
#include <cstdio>
namespace cg = cooperative_groups;

#ifndef MULTI
#define MULTI 0
#endif

#ifdef NO_SCAN
#define U_SCAN(x) do{}while(0)
#else
#define U_SCAN(x) x
#endif
#ifdef NO_S5
#define U_S5(x) do{}while(0)
#else
#define U_S5(x) x
#endif
#ifdef NO_AS
#define U_AS(x) do{}while(0)
#else
#define U_AS(x) x
#endif
#ifdef NO_AP
#define U_AP(x) do{}while(0)
#else
#define U_AP(x) x
#endif
#ifdef NO_RP
#define U_RP(x) do{}while(0)
#else
#define U_RP(x) x
#endif
#ifdef NO_GEMM
#define U_GEMM(x) do{}while(0)
#else
#define U_GEMM(x) x
#endif
#ifdef NO_INIT
#define U_INIT(x) do{}while(0)
#else
#define U_INIT(x) x
#endif
#ifdef NO_CC
#define U_CC(x) do{}while(0)
#else
#define U_CC(x) x
#endif
#define DI __device__ __forceinline__
typedef unsigned short bfu;
using bf16x8 = __attribute__((ext_vector_type(8))) short;
using s16x4  = __attribute__((ext_vector_type(4))) short;
using f32x4  = __attribute__((ext_vector_type(4))) float;
using f32x16 = __attribute__((ext_vector_type(16))) float;

constexpr int NT = 512;
constexpr int MP = 65536, MS = 512, SP = 8192, TS = 32, SKP = 4160, SKS = 4128;
constexpr float ALPHA = 1.4142135623730951f;
constexpr float QSCALE = 0.10206207261596575f * 1.4426950408889634f;
constexpr size_t MiB = 1048576;

constexpr size_t LW_WIN = 0;
constexpr size_t LW_WQB = LW_WIN + (size_t)2048 * 1024 * 2;
constexpr size_t LW_WKV = LW_WQB + 768 * 256 * 2;
constexpr size_t LW_WGLU = LW_WKV + 768 * 128 * 2;
constexpr size_t LW_WOUT = LW_WGLU + 256 * 256 * 2;
constexpr size_t LW_WUP = LW_WOUT + 1024 * 1024 * 2;
constexpr size_t LW_WDN = LW_WUP + (size_t)4096 * 1024 * 2;
constexpr size_t LW_STRIDE = 23 * MiB;
constexpr size_t OFF_X = 46 * MiB;
constexpr size_t OFF_XS = 174 * MiB;
constexpr size_t OFF_TAB = 175 * MiB;
constexpr size_t OFF_CTL = 176 * MiB;
constexpr size_t OFF_SS = 177 * MiB;
constexpr size_t OFF_P = 233 * MiB;
constexpr size_t S_QL = OFF_SS;
constexpr size_t S_KVL = S_QL + 512 * 256 * 2;
constexpr size_t S_U = S_KVL + 512 * 160 * 2;
constexpr size_t S_PR = S_U + 512 * 256 * 2;
constexpr size_t S_Q = S_PR + 512 * 1280 * 2;
constexpr size_t S_QABS = S_Q + 512 * 576 * 2;
constexpr size_t S_RW = S_QABS + 16 * 6 * 32 * 160 * 2;
constexpr size_t S_G = S_RW + 16 * 6 * 32 * 384 * 2;
constexpr size_t S_BON = S_G + 512 * 384 * 2;
constexpr size_t S_Y = S_BON + 512 * 6 * 4;
constexpr size_t S_MERGED = S_Y + 512 * 384 * 2;
constexpr size_t S_Z = S_MERGED + 512 * 1024 * 2;
constexpr size_t S_HID = S_Z + 512 * 1024 * 4;
constexpr size_t S_KCAT = S_HID + 512 * 4096 * 2;
constexpr size_t S_VT = S_KCAT + (size_t)16 * SKP * 160 * 2;
constexpr size_t S_END = S_VT + (size_t)16 * 128 * SKP * 2;
static_assert(S_END <= OFF_P, "sample scratch overflow");
constexpr size_t P_QL = OFF_P;
constexpr size_t P_KVL = OFF_P + 32 * MiB;
constexpr size_t P_PR = OFF_P + 52 * MiB;
constexpr size_t P_U = OFF_P + 212 * MiB;
constexpr size_t P_Q = OFF_P + 244 * MiB;
constexpr size_t P_KB = OFF_P + 316 * MiB;
constexpr size_t P_VT = OFF_P + 388 * MiB;
constexpr size_t P_RW = OFF_P + 436 * MiB;
constexpr size_t P_G = OFF_P + 724 * MiB;
constexpr size_t P_BON = OFF_P + 772 * MiB;
constexpr size_t P_MERGED = OFF_P;
constexpr size_t P_Y = OFF_P + 128 * MiB;
constexpr size_t P_Z1 = OFF_P + 212 * MiB;
constexpr size_t P_HID = OFF_P;
constexpr size_t P_Z2 = OFF_P + 512 * MiB;
constexpr size_t WS_NEED = OFF_P + 774 * MiB;

constexpr size_t O_YP = 0;
constexpr size_t O_YS = 67108864;
constexpr size_t O_CKVP = O_YS + 524288;
constexpr size_t O_KRP = O_CKVP + 16777216;
constexpr size_t O_S5P = O_KRP + 4194304;
constexpr size_t O_RWP = O_S5P + 32768;
constexpr size_t O_SHP = O_RWP + 393216;
constexpr size_t O_CKVS = O_SHP + 20480;
constexpr size_t O_KRS = O_CKVS + 131072;
constexpr size_t O_S5S = O_KRS + 32768;
constexpr size_t O_RWS = O_S5S + 65536;
constexpr size_t O_SHS = O_RWS + 786432;

enum { I_XP = 0, I_XS, I_CCKV, I_CKR, I_SS5, I_SRW, I_SSH, I_WIN, I_QG, I_WQB, I_KVG, I_WKVB, I_LRE, I_LIM, I_LDT, I_BRE, I_BIM,
       I_CRE, I_CIM, I_S5D, I_WGLU, I_BGLU, I_MU, I_W0, I_WW2, I_A0, I_WA2, I_WG2, I_KK, I_KA, I_RK, I_GNG, I_GNB, I_WOUT,
       I_LN1G, I_LN1B, I_WUP, I_WDN, I_LN2G, I_LN2B };

struct Params { const float* in[40]; float* out; char* ws; int wave; int pad_; };
DI int opaque0() { int z; asm volatile("s_mov_b32 %0, 0" : "=s"(z)); return z; }
DI int lane_id() { return (int)__builtin_amdgcn_mbcnt_hi(~0u, __builtin_amdgcn_mbcnt_lo(~0u, 0u)); }
DI int ltid(const Params& p) { return p.wave * 64 + lane_id(); }
DI Params relaunder(const Params& p) {
  Params q; const int z = opaque0();
  _Pragma("unroll") for (int i = 0; i < 40; ++i) q.in[i] = p.in[i] + z;
  q.out = p.out + z; q.ws = p.ws + z; q.wave = p.wave + z; q.pad_ = 0; return q;
}


constexpr int SHM_MAIN = 131072;
constexpr int SHM_BYTES = SHM_MAIN + 2048;

DI float bf2f(bfu x) { return __uint_as_float(((unsigned)x) << 16); }
DI bfu f2bf(float f) { __bf16 b = (__bf16)f; return __builtin_bit_cast(unsigned short, b); }
DI unsigned pack2(float a, float b) { return (unsigned)f2bf(a) | ((unsigned)f2bf(b) << 16); }
DI float wave_sum(float v) { for (int o = 32; o > 0; o >>= 1) v += __shfl_xor(v, o); return v; }
template <int CTRL> DI float dppf(float x) { return __int_as_float(__builtin_amdgcn_update_dpp(0, __float_as_int(x), CTRL, 0xF, 0xF, false)); }
DI float allred16(float x) { x += dppf<0x128>(x); x += dppf<0x124>(x); x += dppf<0x122>(x); x += dppf<0x121>(x); return x; }
DI float sigmoidf_(float x) { return 1.f / (1.f + __expf(-x)); }
DI float tanhf_(float x) { return 1.f - 2.f / (__expf(2.f * x) + 1.f); }
DI int crow(int reg, int h) { return (reg & 3) + 8 * (reg >> 2) + 4 * h; }

DI void tr_weight(const float* src, int K, int N, int Np, const float* scale, bfu* dst, char* shm, const int tid) {
  float* tile = (float*)shm;
  const int ntk = K / 64, ntn = Np / 64;
  for (int t = blockIdx.x; t < ntk * ntn; t += gridDim.x) {
    const int k0 = (t % ntk) * 64, n0 = (t / ntk) * 64;
    for (int e = tid; e < 4096; e += NT) {
      int r = e >> 6, c = e & 63;
      float v = 0.f;
      if (n0 + c < N) { v = src[(long)(k0 + r) * N + n0 + c]; if (scale) v *= scale[k0 + r]; }
      tile[r * 65 + c] = v;
    }
    __syncthreads();
    for (int e = tid; e < 4096; e += NT) {
      int rn = e >> 6, ck = e & 63;
      dst[(long)(n0 + rn) * K + k0 + ck] = f2bf(tile[ck * 65 + rn]);
    }
    __syncthreads();
  }
}

DI void phase_init(const Params& pin, char* shm) {
  const Params p = relaunder(pin);
  const int tid = ltid(p);
  const long gtid = (long)blockIdx.x * NT + tid, gsz = (long)gridDim.x * NT;
  if (blockIdx.x == 0) for (int i = tid; i < 1024; i += NT) ((unsigned*)(p.ws + OFF_CTL))[i] = 0u;
  float2* tab = (float2*)(p.ws + OFF_TAB);
  for (long i = gtid; i < 8192 * 16; i += gsz) {
    int pos = (int)(i >> 4), k = (int)(i & 15);
    const float inv = exp2f(-(float)k * 0.8304820237218406f);
    const float ang = (float)pos * inv;
    const float s = sinf(ang), c = cosf(ang);
    tab[i] = make_float2(c, s);
  }
  for (int l = 0; l < 2; ++l) {
    char* wb = p.ws + l * LW_STRIDE;
    tr_weight(p.in[I_WIN] + (size_t)l * 1024 * 1952, 1024, 1952, 2048, nullptr, (bfu*)(wb + LW_WIN), shm, tid);
    tr_weight(p.in[I_WQB] + (size_t)l * 256 * 576, 256, 576, 768, p.in[I_QG] + l * 256, (bfu*)(wb + LW_WQB), shm, tid);
    tr_weight(p.in[I_WKVB] + (size_t)l * 128 * 768, 128, 768, 768, p.in[I_KVG] + l * 128, (bfu*)(wb + LW_WKV), shm, tid);
    tr_weight(p.in[I_WGLU] + (size_t)l * 256 * 256, 256, 256, 256, nullptr, (bfu*)(wb + LW_WGLU), shm, tid);
    tr_weight(p.in[I_WOUT] + (size_t)l * 1024 * 1024, 1024, 1024, 1024, nullptr, (bfu*)(wb + LW_WOUT), shm, tid);
    tr_weight(p.in[I_WUP] + (size_t)l * 1024 * 4096, 1024, 4096, 4096, nullptr, (bfu*)(wb + LW_WUP), shm, tid);
    tr_weight(p.in[I_WDN] + (size_t)l * 4096 * 1024, 4096, 1024, 1024, nullptr, (bfu*)(wb + LW_WDN), shm, tid);
  }
  {
    const float4* xp = (const float4*)p.in[I_XP]; uint2* X = (uint2*)(p.ws + OFF_X);
    for (long i = gtid; i < (long)MP * 256; i += gsz) { float4 v = xp[i]; X[i] = make_uint2(pack2(v.x, v.y), pack2(v.z, v.w)); }
    const float4* xs = (const float4*)p.in[I_XS]; uint2* XS = (uint2*)(p.ws + OFF_XS);
    for (long i = gtid; i < (long)MS * 256; i += gsz) { float4 v = xs[i]; XS[i] = make_uint2(pack2(v.x, v.y), pack2(v.z, v.w)); }
  }
}

constexpr int BM = 256, BK = 64, HALF = 128, NXCD = 8, WGM = 8, HT = HALF * BK;
DI int lds_byte(int r, int c) {
  int st = (r >> 4) * 2 + (c >> 5), rr = r & 15, cc = c & 31, ob = rr * 64 + cc * 2;
  return st * 1024 + (ob ^ (((ob >> 9) & 1) << 5));
}
DI void stage_rc(int b, int& R, int& C) {
  int st = b / 1024, sb = b % 1024, swz = sb ^ (((sb >> 9) & 1) << 5);
  R = (st >> 1) * 16 + swz / 64; C = (st & 1) * 32 + (swz % 64) / 2;
}
enum { K_PROJ = 0, K_Q, K_KV, K_GLU, K_RES1, K_UP, K_RES2 };
struct Job { const bfu* A; const bfu* Bt; int lda, ldb, M, N, K, kind, samp; };

DI void gemm_tile(const bfu* A, const bfu* Bt, const int lda, const int ldb, const int K, const int brow, const int bcol,
                  bfu* shm, f32x4 (&acc)[2][2][4][2], const int tidg) {
#define SA(b, h) (shm + ((b) * 2 + (h)) * HT)
#define SB(b, h) (shm + (4 + (b) * 2 + (h)) * HT)
#define STAGE(P, BASE, LD, OFF, br, kt) do { const char* _gb = (const char*)((BASE) + ((long)(br) * (LD) + (long)(kt) * BK)); \
    asm volatile("" : "+s"(_gb)); \
    _Pragma("unroll") for (int _i = 0; _i < 2; ++_i) { \
      __builtin_amdgcn_global_load_lds((const unsigned*)(_gb + (long)_i * 128 * (LD) + OFF), \
        (__attribute__((address_space(3))) unsigned*)((char*)(P) + wv1024 + _i * 8192), 16, 0, 0); } } while (0)
#define LDA(dst, b, h) _Pragma("unroll") for (int m = 0; m < 4; ++m) _Pragma("unroll") for (int k = 0; k < 2; ++k) \
    dst[m][k] = *reinterpret_cast<const bf16x8*>((const char*)SA(b, h) + la + (m * 2048 + k * 1024))
#define LDB(dst, b, h) _Pragma("unroll") for (int n = 0; n < 2; ++n) _Pragma("unroll") for (int k = 0; k < 2; ++k) \
    dst[n][k] = *reinterpret_cast<const bf16x8*>((const char*)SB(b, h) + lb + (n * 2048 + k * 1024))
#define MMA(ai, bj, At, Bx) do { __builtin_amdgcn_s_setprio(1); \
    _Pragma("unroll") for (int m = 0; m < 4; ++m) _Pragma("unroll") for (int n = 0; n < 2; ++n) _Pragma("unroll") for (int k = 0; k < 2; ++k) \
      acc[ai][bj][m][n] = __builtin_amdgcn_mfma_f32_16x16x32_bf16(At[m][k], Bx[n][k], acc[ai][bj][m][n], 0, 0, 0); \
    __builtin_amdgcn_s_setprio(0); } while (0)
#define WAIT_V(n) asm volatile("s_waitcnt vmcnt(" #n ")" ::: "memory")
#define WAIT_L(n) asm volatile("s_waitcnt lgkmcnt(" #n ")" ::: "memory")
#define BAR __builtin_amdgcn_s_barrier()
#define SCHED __builtin_amdgcn_sched_barrier(0)
  const int tb16 = tidg * 16;
  const int wv1024 = __builtin_amdgcn_readfirstlane(tidg >> 6) * 1024;
  const int wid = tidg >> 6, lane = tidg & 63, wr = wid >> 2, wc = wid & 3, fr = lane & 15, fq = lane >> 4;
  _Pragma("unroll") for (int a = 0; a < 2; ++a) _Pragma("unroll") for (int b = 0; b < 2; ++b) _Pragma("unroll") for (int m = 0; m < 4; ++m) _Pragma("unroll") for (int n = 0; n < 2; ++n) acc[a][b][m][n] = f32x4{0.f, 0.f, 0.f, 0.f};
  bf16x8 At[4][2], B0[2][2], B1[2][2];
  const int nt = K / BK;
  unsigned aoff, boff;
  { int _r, _c; stage_rc(tb16, _r, _c); aoff = (unsigned)(_r * lda + _c) * 2u; boff = (unsigned)(_r * ldb + _c) * 2u; }
  const int sw_ = (fr * 64 + fq * 16) ^ ((((fr * 64 + fq * 16) >> 9) & 1) << 5);
  const int la = wr * 8192 + sw_, lb = wc * 4096 + sw_;
  STAGE(SB(0, 0), Bt, ldb, boff, bcol, 0); STAGE(SA(0, 0), A, lda, aoff, brow, 0);
  STAGE(SB(0, 1), Bt, ldb, boff, bcol + HALF, 0); STAGE(SA(0, 1), A, lda, aoff, brow + HALF, 0);
  if (wr == 1) BAR;
  WAIT_V(4); BAR;
  STAGE(SB(1, 0), Bt, ldb, boff, bcol, 1); STAGE(SA(1, 0), A, lda, aoff, brow, 1); STAGE(SB(1, 1), Bt, ldb, boff, bcol + HALF, 1);
  WAIT_V(6); BAR;
  for (int t = 0; t < nt - 2; t += 2) {
    LDB(B0, 0, 0); SCHED; LDA(At, 0, 0); STAGE(SA(1, 1), A, lda, aoff, brow + HALF, t + 1);
    WAIT_L(8); BAR; WAIT_L(0); MMA(0, 0, At, B0); BAR; SCHED;
    LDB(B1, 0, 1); STAGE(SB(0, 0), Bt, ldb, boff, bcol, t + 2);
    BAR; WAIT_L(0); MMA(0, 1, At, B1); BAR;
    LDA(At, 0, 1); STAGE(SA(0, 0), A, lda, aoff, brow, t + 2);
    BAR; WAIT_L(0); MMA(1, 0, At, B0); BAR; SCHED;
    STAGE(SB(0, 1), Bt, ldb, boff, bcol + HALF, t + 2);
    WAIT_V(6); BAR; MMA(1, 1, At, B1); BAR;
    LDB(B0, 1, 0); SCHED; LDA(At, 1, 0); STAGE(SA(0, 1), A, lda, aoff, brow + HALF, t + 2);
    WAIT_L(8); BAR; WAIT_L(0); MMA(0, 0, At, B0); BAR; SCHED;
    LDB(B1, 1, 1); STAGE(SB(1, 0), Bt, ldb, boff, bcol, t + 3);
    BAR; WAIT_L(0); MMA(0, 1, At, B1); BAR;
    LDA(At, 1, 1); STAGE(SA(1, 0), A, lda, aoff, brow, t + 3);
    BAR; WAIT_L(0); MMA(1, 0, At, B0); BAR; SCHED;
    STAGE(SB(1, 1), Bt, ldb, boff, bcol + HALF, t + 3);
    WAIT_V(6); BAR; MMA(1, 1, At, B1); BAR;
  }
  { LDB(B0, 0, 0); LDA(At, 0, 0); STAGE(SA(1, 1), A, lda, aoff, brow + HALF, nt - 1);
    BAR; WAIT_L(0); MMA(0, 0, At, B0); BAR;
    LDB(B1, 0, 1); BAR; WAIT_L(0); MMA(0, 1, At, B1); BAR;
    LDA(At, 0, 1); WAIT_V(4); BAR; WAIT_L(0); MMA(1, 0, At, B0); MMA(1, 1, At, B1); BAR; }
  { LDB(B0, 1, 0); LDA(At, 1, 0); WAIT_V(2); BAR; WAIT_L(0); MMA(0, 0, At, B0); BAR;
    LDB(B1, 1, 1); WAIT_V(0); BAR; WAIT_L(0); MMA(0, 1, At, B1); BAR;
    LDA(At, 1, 1); BAR; WAIT_L(0); MMA(1, 0, At, B0); MMA(1, 1, At, B1); BAR; }
  if (wr == 0) BAR;
}

template <class F>
DI void epi_loop(f32x4 (&acc)[2][2][4][2], int wr, int wc, int fq, F f) {
  _Pragma("unroll") for (int ai = 0; ai < 2; ++ai) _Pragma("unroll") for (int bj = 0; bj < 2; ++bj) _Pragma("unroll") for (int m = 0; m < 4; ++m)
    f(ai * 128 + wr * 64 + m * 16 + fq * 4, bj * 128 + wc * 32, acc[ai][bj][m][0], acc[ai][bj][m][1]);
}

DI void gemm_epilogue(const Params& pin, const Job& jb, int layer, int brow, int bcol, f32x4 (&acc)[2][2][4][2], const float* rs) {
  const Params p = relaunder(pin);
  const int tide = ltid(p);
  const int wid = tide >> 6, lane = tide & 63, wr = wid >> 2, wc = wid & 3, fr = lane & 15, fq = lane >> 4;
  const int samp = jb.samp, T = samp ? TS : SP, kind = jb.kind;
  char* ws = p.ws;
  if (kind == K_PROJ) {
    bfu* QL = (bfu*)(ws + (samp ? S_QL : P_QL)); bfu* KVL = (bfu*)(ws + (samp ? S_KVL : P_KVL));
    bfu* U = (bfu*)(ws + (samp ? S_U : P_U)); bfu* PR = (bfu*)(ws + (samp ? S_PR : P_PR));
    float* osh = p.out + (samp ? O_SHS : O_SHP) + (size_t)layer * (samp ? 16 : 8) * 1280;
    epi_loop(acc, wr, wc, fq, [&](int rl, int cbl, const f32x4& v0, const f32x4& v1) {
      const int r0 = brow + rl;
      _Pragma("unroll") for (int n = 0; n < 2; ++n) {
        const f32x4 v = n ? v1 : v0;
        const int c = bcol + cbl + n * 16 + fr;
        bfu* dst; int ld, cc;
        if (c < 256) { dst = QL; ld = 256; cc = c; }
        else if (c < 416) { dst = KVL; ld = 160; cc = c - 256; }
        else if (c < 672) { dst = U; ld = 256; cc = c - 416; }
        else { dst = PR; ld = 1280; cc = c - 672; }
        if (c < 1952) {
          _Pragma("unroll") for (int j = 0; j < 4; ++j) dst[(long)(r0 + j) * ld + cc] = f2bf(v[j]);
          if (c >= 672) {
            _Pragma("unroll") for (int j = 0; j < 4; ++j) { const int r = r0 + j; if ((r % T) == T - 1) osh[(size_t)(r / T) * 1280 + (c - 672)] = v[j]; }
          }
        }
      }
    });
  } else if (kind == K_KV) {
    bfu* KB = (bfu*)(ws + P_KB); bfu* VT = (bfu*)(ws + P_VT);
    epi_loop(acc, wr, wc, fq, [&](int rl, int cbl, const f32x4& v0, const f32x4& v1) {
      const int r0 = brow + rl; const int b = r0 / SP, t0 = r0 % SP;
      const float s0 = rs[rl], s1 = rs[rl + 1], s2 = rs[rl + 2], s3 = rs[rl + 3];
      _Pragma("unroll") for (int n = 0; n < 2; ++n) {
        const f32x4 v = n ? v1 : v0;
        const int c = bcol + cbl + n * 16 + fr; const int h = c >> 7, w = c & 127;
        if (w < 64) {
          bfu* kp = KB + ((long)(b * 6 + h) * SP + t0) * 96 + w;
          kp[0] = f2bf(v[0] * s0); kp[96] = f2bf(v[1] * s1); kp[192] = f2bf(v[2] * s2); kp[288] = f2bf(v[3] * s3);
        } else {
          *(uint2*)(VT + ((long)(b * 6 + h) * 64 + (w - 64)) * SP + t0) = make_uint2(pack2(v[0] * s0, v[1] * s1), pack2(v[2] * s2, v[3] * s3));
        }
      }
    });
  } else if (kind == K_GLU) {
    const bfu* U = (const bfu*)(ws + (samp ? S_U : P_U)); bfu* MG = (bfu*)(ws + (samp ? S_MERGED : P_MERGED));
    const float* bgl = p.in[I_BGLU] + layer * 256;
    epi_loop(acc, wr, wc, fq, [&](int rl, int cbl, const f32x4& v0, const f32x4& v1) {
      const int r0 = brow + rl;
      _Pragma("unroll") for (int n = 0; n < 2; ++n) {
        const f32x4 v = n ? v1 : v0;
        const int c = bcol + cbl + n * 16 + fr; const float bg = bgl[c];
        _Pragma("unroll") for (int j = 0; j < 4; ++j) { const long r = r0 + j; const float z = bf2f(U[r * 256 + c]);
          MG[r * 1024 + 384 + c] = f2bf(z * sigmoidf_(v[j] + bg)); }
      }
    });
  } else if (kind == K_RES1 || kind == K_RES2) {
    float* Z = (float*)(ws + (samp ? S_Z : (kind == K_RES1 ? P_Z1 : P_Z2)));
    const bfu* X = (const bfu*)(ws + (samp ? OFF_XS : OFF_X));
    epi_loop(acc, wr, wc, fq, [&](int rl, int cbl, const f32x4& v0, const f32x4& v1) {
      const int r0 = brow + rl;
      _Pragma("unroll") for (int n = 0; n < 2; ++n) {
        const f32x4 v = n ? v1 : v0;
        const int c = bcol + cbl + n * 16 + fr;
        _Pragma("unroll") for (int j = 0; j < 4; ++j) { const long r = r0 + j; Z[r * 1024 + c] = ALPHA * bf2f(X[r * 1024 + c]) + v[j]; }
      }
    });
  } else if (kind == K_UP) {
    bfu* H = (bfu*)(ws + (samp ? S_HID : P_HID));
    epi_loop(acc, wr, wc, fq, [&](int rl, int cbl, const f32x4& v0, const f32x4& v1) {
      const int r0 = brow + rl;
      _Pragma("unroll") for (int n = 0; n < 2; ++n) {
        const f32x4 v = n ? v1 : v0;
        const int c = bcol + cbl + n * 16 + fr;
        _Pragma("unroll") for (int j = 0; j < 4; ++j) { const long r = r0 + j; const float x = fmaxf(v[j], 0.f); H[r * 4096 + c] = f2bf(x * x); }
      }
    });
  } else {
    bfu* Q = (bfu*)(ws + (samp ? S_Q : P_Q));
    const float2* tab = (const float2*)(ws + OFF_TAB);
    epi_loop(acc, wr, wc, fq, [&](int rl, int cbl, const f32x4& v0, const f32x4& v1) {
      const int r0 = brow + rl; const int cb = bcol + cbl;
      if (cb < 576) {
        const bool rope = (cb % 96) == 64;
        _Pragma("unroll") for (int j = 0; j < 4; ++j) {
          const int r = r0 + j; const float s = rs[rl + j];
          float a = v0[j] * s, b = v1[j] * s;
          if (rope) { const int pos = (r % T) + (samp ? 4096 : 0); const float2 cs = tab[pos * 16 + fr];
            const float a2 = a * cs.x - b * cs.y, b2 = b * cs.x + a * cs.y; a = a2; b = b2; }
          Q[(long)r * 576 + cb + fr] = f2bf(a); Q[(long)r * 576 + cb + 16 + fr] = f2bf(b);
        }
      }
    });
  }
}

DI Job get_job(const Params& pin, int kind, int layer, int samp) {
  const Params p = relaunder(pin);
  char* ws = p.ws; char* wb = ws + layer * LW_STRIDE;
  Job j; j.kind = kind; j.samp = samp; j.M = samp ? MS : MP;
  switch (kind) {
    case K_PROJ: j.A = (const bfu*)(ws + (samp ? OFF_XS : OFF_X)); j.lda = 1024; j.Bt = (const bfu*)(wb + LW_WIN); j.ldb = 1024; j.N = 2048; j.K = 1024; break;
    case K_Q: j.A = (const bfu*)(ws + (samp ? S_QL : P_QL)); j.lda = 256; j.Bt = (const bfu*)(wb + LW_WQB); j.ldb = 256; j.N = 768; j.K = 256; break;
    case K_KV: j.A = (const bfu*)(ws + P_KVL); j.lda = 160; j.Bt = (const bfu*)(wb + LW_WKV); j.ldb = 128; j.N = 768; j.K = 128; break;
    case K_GLU: j.A = (const bfu*)(ws + (samp ? S_U : P_U)); j.lda = 256; j.Bt = (const bfu*)(wb + LW_WGLU); j.ldb = 256; j.N = 256; j.K = 256; break;
    case K_RES1: j.A = (const bfu*)(ws + (samp ? S_MERGED : P_MERGED)); j.lda = 1024; j.Bt = (const bfu*)(wb + LW_WOUT); j.ldb = 1024; j.N = 1024; j.K = 1024; break;
    case K_UP: j.A = (const bfu*)(ws + (samp ? OFF_XS : OFF_X)); j.lda = 1024; j.Bt = (const bfu*)(wb + LW_WUP); j.ldb = 1024; j.N = 4096; j.K = 1024; break;
    default: j.A = (const bfu*)(ws + (samp ? S_HID : P_HID)); j.lda = 4096; j.Bt = (const bfu*)(wb + LW_WDN); j.ldb = 4096; j.N = 1024; j.K = 4096; break;
  }
  return j;
}

DI void gemm_do_tile(const Params& pin, const Job& jb, int layer, int wgid, char* shm) {
  const Params p = relaunder(pin);
  const int nM = jb.M / BM, nN = jb.N / BM, nwg = nM * nN;
  { int q = nwg / NXCD, r = nwg % NXCD, xcd = wgid % NXCD, off = wgid / NXCD;
    wgid = (xcd < r ? xcd * (q + 1) : r * (q + 1) + (xcd - r) * q) + off; }
  const int nig = WGM * nN, gid = wgid / nig, fm = gid * WGM, gsz = min(nM - fm, WGM);
  const int pm = fm + ((wgid % nig) % gsz), pn = (wgid % nig) / gsz, brow = pm * BM, bcol = pn * BM;
  f32x4 acc[2][2][4][2];
  gemm_tile(jb.A, jb.Bt, jb.lda, jb.ldb, jb.K, brow, bcol, (bfu*)shm, acc, ltid(p));
  float* rs = (float*)(shm + SHM_MAIN);
  if (jb.kind == K_Q || jb.kind == K_KV) {
    const int tid = ltid(p), row = tid >> 1, half = tid & 1, kh = jb.K / 2;
    const bfu* ap = jb.A + (long)(brow + row) * jb.lda + half * kh;
    float ss = 0.f;
    for (int i = 0; i < kh; i += 8) { uint4 u = *(const uint4*)(ap + i);
      unsigned w[4] = {u.x, u.y, u.z, u.w};
      _Pragma("unroll") for (int k = 0; k < 4; ++k) { float a = bf2f(w[k] & 0xffff), b = bf2f(w[k] >> 16); ss += a * a + b * b; } }
    ss += __shfl_xor(ss, 1);
    float inv = rsqrtf(ss / (float)jb.K + 1e-6f);
    if (jb.kind == K_Q) inv *= QSCALE;
    if (half == 0) rs[row] = inv;
  }
  __syncthreads();
  gemm_epilogue(p, jb, layer, brow, bcol, acc, rs);
  __syncthreads();
}

DI void ln_rows(const Params& pin, int layer, int which  , int final_) {
  const Params p = relaunder(pin);
  const int tidw = ltid(p); const int wave = tidw >> 6, lane = tidw & 63;
  const float* g = p.in[which ? I_LN2G : I_LN1G] + layer * 1024;
  const float* bta = p.in[which ? I_LN2B : I_LN1B] + layer * 1024;
  for (int row = blockIdx.x * 8 + wave; row < MP + MS; row += gridDim.x * 8) {
    const int samp = row >= MP; const long r = samp ? row - MP : row;
    const float* Z = (const float*)(p.ws + (samp ? S_Z : (which ? P_Z2 : P_Z1))) + r * 1024;
    float4 v[4]; float s = 0.f;
    _Pragma("unroll") for (int k = 0; k < 4; ++k) { v[k] = *(const float4*)(Z + k * 256 + lane * 4); s += v[k].x + v[k].y + v[k].z + v[k].w; }
    const float mu = wave_sum(s) * (1.f / 1024);
    float q = 0.f;
    _Pragma("unroll") for (int k = 0; k < 4; ++k) { float a = v[k].x - mu, b = v[k].y - mu, c = v[k].z - mu, d = v[k].w - mu; q += a * a + b * b + c * c + d * d; }
    const float rstd = rsqrtf(wave_sum(q) * (1.f / 1024) + 1e-5f);
    bfu* X = (bfu*)(p.ws + (samp ? OFF_XS : OFF_X)) + r * 1024;
    float* O = p.out + (samp ? O_YS : O_YP) + r * 1024;
    _Pragma("unroll") for (int k = 0; k < 4; ++k) {
      const int c = k * 256 + lane * 4;
      float4 gg = *(const float4*)(g + c), bb = *(const float4*)(bta + c);
      float o0 = (v[k].x - mu) * rstd * gg.x + bb.x, o1 = (v[k].y - mu) * rstd * gg.y + bb.y;
      float o2 = (v[k].z - mu) * rstd * gg.z + bb.z, o3 = (v[k].w - mu) * rstd * gg.w + bb.w;
      if (final_) *(float4*)(O + c) = make_float4(o0, o1, o2, o3);
      else *(uint2*)(X + c) = make_uint2(pack2(o0, o1), pack2(o2, o3));
    }
  }
}

DI void mla_prep_unit(const Params& pin, int layer, int samp, int unit) {
  const Params p = relaunder(pin);
  const int tidw = ltid(p); const int wave = tidw >> 6, lane = tidw & 63;
  const int T = samp ? TS : SP;
  const bfu* KVL = (const bfu*)(p.ws + (samp ? S_KVL : P_KVL));
  const float2* tab = (const float2*)(p.ws + OFF_TAB);
  const float g0 = p.in[I_KVG][layer * 128 + 2 * lane], g1 = p.in[I_KVG][layer * 128 + 2 * lane + 1];
  for (int i = 0; i < 8; ++i) {
    const int r = unit * 64 + i * 8 + wave; const int b = r / T, t = r % T;
    unsigned pr = *(const unsigned*)(KVL + (long)r * 160 + lane * 2);
    float x0 = bf2f(pr & 0xffff), x1 = bf2f(pr >> 16);
    float ss = wave_sum(x0 * x0 + x1 * x1);
    float inv = rsqrtf(ss * (1.f / 128) + 1e-6f);
    float c0 = x0 * inv * g0, c1 = x1 * inv * g1;
    if (!samp) {
      *(float2*)(p.out + O_CKVP + ((size_t)(layer * 8 + b) * SP + t) * 128 + 2 * lane) = make_float2(c0, c1);
    } else {
      *(float2*)(p.out + O_CKVS + ((size_t)(layer * 16 + b) * TS + t) * 128 + 2 * lane) = make_float2(c0, c1);
      bfu* KC = (bfu*)(p.ws + S_KCAT); bfu* VT = (bfu*)(p.ws + S_VT);
      *(unsigned*)(KC + ((long)b * SKP + 4096 + t) * 160 + 2 * lane) = pack2(c0, c1);
      VT[((long)b * 128 + 2 * lane) * SKP + 4096 + t] = f2bf(c0);
      VT[((long)b * 128 + 2 * lane + 1) * SKP + 4096 + t] = f2bf(c1);
    }
    if (lane < 16) {
      float xa = bf2f(KVL[(long)r * 160 + 128 + lane]), xb = bf2f(KVL[(long)r * 160 + 144 + lane]);
      const int pos = t + (samp ? 4096 : 0);
      float2 cs = tab[pos * 16 + lane];
      float o1 = xa * cs.x - xb * cs.y, o2 = xb * cs.x + xa * cs.y;
      if (!samp) {
        float* o = p.out + O_KRP + ((size_t)(layer * 8 + b) * SP + t) * 32; o[lane] = o1; o[lane + 16] = o2;
        bfu* KB = (bfu*)(p.ws + P_KB);
        for (int h = 0; h < 6; ++h) { bfu* kr = KB + ((long)(b * 6 + h) * SP + t) * 96 + 64; kr[lane] = f2bf(o1); kr[lane + 16] = f2bf(o2); }
      } else {
        float* o = p.out + O_KRS + ((size_t)(layer * 16 + b) * TS + t) * 32; o[lane] = o1; o[lane + 16] = o2;
        bfu* kr = (bfu*)(p.ws + S_KCAT) + ((long)b * SKP + 4096 + t) * 160 + 128; kr[lane] = f2bf(o1); kr[lane + 16] = f2bf(o2);
      }
    }
  }
}

DI void cache_conv_unit(const Params& pin, int layer, int unit, char* shm) {
  const Params p = relaunder(pin);
  const int tid = ltid(p), b = unit >> 6, t0 = (unit & 63) * 64;
  const float* ck = p.in[I_CCKV] + ((size_t)(layer * 16 + b) * 4096 + t0) * 128;
  const float* kr = p.in[I_CKR] + ((size_t)(layer * 16 + b) * 4096 + t0) * 32;
  bfu* KC = (bfu*)(p.ws + S_KCAT) + ((long)b * SKP + t0) * 160; bfu* VT = (bfu*)(p.ws + S_VT) + (long)b * 128 * SKP + t0;
  bfu* tl = (bfu*)shm;
  _Pragma("unroll") for (int i = 0; i < 4; ++i) { int e = tid + i * NT, tok = e >> 5, c4 = (e & 31) * 4;
    float4 v = *(const float4*)(ck + tok * 128 + c4);
    *(uint2*)(KC + (long)tok * 160 + c4) = make_uint2(pack2(v.x, v.y), pack2(v.z, v.w));
    tl[(c4 + 0) * 72 + tok] = f2bf(v.x); tl[(c4 + 1) * 72 + tok] = f2bf(v.y); tl[(c4 + 2) * 72 + tok] = f2bf(v.z); tl[(c4 + 3) * 72 + tok] = f2bf(v.w); }
  _Pragma("unroll") for (int i = 0; i < 4; ++i) { int e = tid + i * NT, tok = e >> 5, c = e & 31; KC[(long)tok * 160 + 128 + c] = f2bf(kr[tok * 32 + c]); }
  __syncthreads();
  _Pragma("unroll") for (int i = 0; i < 2; ++i) { int e = tid + i * NT, c = e >> 3, part = e & 7;
    *(uint4*)(VT + (long)c * SKP + part * 8) = *(const uint4*)(tl + c * 72 + part * 8); }
  __syncthreads();
}

DI void rwkv_prep_unit(const Params& pin, int layer, int samp, int unit, char* shm) {
  const Params p = relaunder(pin);
  const int tid = ltid(p), wave = tid >> 6, lane = tid & 63;
  const int T = samp ? TS : SP; const int r0 = unit * 32, b = r0 / T, t0 = r0 % T;
  const bfu* PR = (const bfu*)(p.ws + (samp ? S_PR : P_PR));
  const float* mu = p.in[I_MU] + layer * 1280;
  const float* sh0 = samp ? p.in[I_SSH] + (size_t)(layer * 16 + b) * 1280 : nullptr;
  float* lor = (float*)shm;
  for (int e = tid; e < 4096; e += NT) {
    const int tk = e >> 7, c = e & 127, col = 1152 + c;
    float cur = bf2f(PR[(long)(r0 + tk) * 1280 + col]);
    float prev = (t0 + tk == 0) ? (sh0 ? sh0[col] : 0.f) : bf2f(PR[(long)(r0 + tk - 1) * 1280 + col]);
    float ps = cur + (prev - cur) * mu[col];
    lor[e] = (c < 32) ? tanhf_(ps) : (c < 64 ? ps : sigmoidf_(ps));
  }
  __syncthreads();
  if (wave < 6) {
    const int h = wave, c = h * 64 + lane;
    bfu* RW = (bfu*)(p.ws + (samp ? S_RW : P_RW)); bfu* G = (bfu*)(p.ws + (samp ? S_G : P_G)); float* BON = (float*)(p.ws + (samp ? S_BON : P_BON));
    {
      float ww[32], wa[32];
      const float* W2 = p.in[I_WW2] + (size_t)layer * 32 * 384, *A2 = p.in[I_WA2] + (size_t)layer * 32 * 384;
      _Pragma("unroll") for (int k = 0; k < 32; ++k) { ww[k] = W2[k * 384 + c]; wa[k] = A2[k * 384 + c]; }
      const float w0 = p.in[I_W0][layer * 384 + c], a0 = p.in[I_A0][layer * 384 + c], kkc = p.in[I_KK][layer * 384 + c],
                  kac = p.in[I_KA][layer * 384 + c], rkc = p.in[I_RK][layer * 384 + c];
      const float mur = mu[c], muk = mu[384 + c], muv = mu[768 + c];
      float pr_, pk_, pv_;
      if (t0 == 0) { pr_ = sh0 ? sh0[c] : 0.f; pk_ = sh0 ? sh0[384 + c] : 0.f; pv_ = sh0 ? sh0[768 + c] : 0.f; }
      else { const bfu* q = PR + (long)(r0 - 1) * 1280; pr_ = bf2f(q[c]); pk_ = bf2f(q[384 + c]); pv_ = bf2f(q[768 + c]); }
      for (int tk = 0; tk < 32; ++tk) {
        const float* lr = lor + tk * 128;
        float accw = w0, acca = a0;
        _Pragma("unroll") for (int k = 0; k < 32; k += 4) { float4 x = *(const float4*)(lr + k);
          accw += x.x * ww[k] + x.y * ww[k + 1] + x.z * ww[k + 2] + x.w * ww[k + 3]; }
        _Pragma("unroll") for (int k = 0; k < 32; k += 4) { float4 x = *(const float4*)(lr + 32 + k);
          acca += x.x * wa[k] + x.y * wa[k + 1] + x.z * wa[k + 2] + x.w * wa[k + 3]; }
        const bfu* q = PR + (long)(r0 + tk) * 1280;
        const float cr = bf2f(q[c]), ck = bf2f(q[384 + c]), cv = bf2f(q[768 + c]);
        const float r = cr + (pr_ - cr) * mur, k = ck + (pk_ - ck) * muk, v = cv + (pv_ - cv) * muv;
        pr_ = cr; pk_ = ck; pv_ = cv;
        const float z = -accw;
        const float sp = fmaxf(z, 0.f) + __logf(1.f + __expf(-fabsf(z)));
        const float wlog = -sp - 0.5f;
        const float e = __expf(wlog);
        const float d = 1.f - __expf(-e);
        const float a = sigmoidf_(acca);
        const float kkr = k * kkc;
        const float n2 = wave_sum(kkr * kkr);
        const float kk = kkr / fmaxf(sqrtf(n2), 1e-12f);
        const float k2 = k * (1.f + (a - 1.f) * kac);
        const float bon = wave_sum(r * k2 * rkc);
        const long tok = (long)(b * 6 + h) * T + t0 + tk;
        bfu* o = RW + tok * 384;
        o[lane] = f2bf(d); o[64 + lane] = f2bf(k2); o[128 + lane] = f2bf(kk); o[192 + lane] = f2bf(-kk * a); o[256 + lane] = f2bf(r); o[320 + lane] = f2bf(v);
        if (lane == 0) BON[(long)(r0 + tk) * 6 + h] = bon;
      }
    }
    {
      float wg[64];
      const float* G2 = p.in[I_WG2] + (size_t)layer * 64 * 384;
      _Pragma("unroll") for (int k = 0; k < 64; ++k) wg[k] = G2[k * 384 + c];
      for (int tk = 0; tk < 32; ++tk) {
        const float* lr = lor + tk * 128;
        float accg = 0.f;
        _Pragma("unroll") for (int k = 0; k < 64; k += 4) { float4 x = *(const float4*)(lr + 64 + k);
          accg += x.x * wg[k] + x.y * wg[k + 1] + x.z * wg[k + 2] + x.w * wg[k + 3]; }
        G[(long)(r0 + tk) * 384 + c] = f2bf(accg);
      }
    }
  }
  __syncthreads();
}

DI void rwkv_scan_unit(const Params& pin, int layer, int samp, int unit, char* shm) {
  const Params p = relaunder(pin);
  const int tid = ltid(p), wave = tid >> 6, lane = tid & 63, rg = lane >> 4, cgi = lane & 15;
  const int T = samp ? TS : SP; const int b = unit / 6, h = unit % 6;
  const int row0 = wave * 8 + rg * 2, col0 = cgi * 4;
  const bfu* RW = (const bfu*)(p.ws + (samp ? S_RW : P_RW)) + (long)unit * T * 384;
  bfu* Y = (bfu*)(p.ws + (samp ? S_Y : P_Y)) + (long)b * T * 384 + h * 64;
  float S[2][4];
  if (samp) { const float* s0 = p.in[I_SRW] + ((size_t)(layer * 16 + b) * 6 + h) * 4096;
    _Pragma("unroll") for (int rr = 0; rr < 2; ++rr) { float4 v = *(const float4*)(s0 + (row0 + rr) * 64 + col0); S[rr][0] = v.x; S[rr][1] = v.y; S[rr][2] = v.z; S[rr][3] = v.w; } }
  else { _Pragma("unroll") for (int rr = 0; rr < 2; ++rr) _Pragma("unroll") for (int c = 0; c < 4; ++c) S[rr][c] = 0.f; }
  const int nch = T / 32;
  uint4 st[3];
  _Pragma("unroll") for (int i = 0; i < 3; ++i) st[i] = *(const uint4*)(RW + (long)(tid + i * NT) * 8);
  for (int ch = 0; ch < nch; ++ch) {
    float* L = (float*)(shm + (ch & 1) * 49152);
    _Pragma("unroll") for (int i = 0; i < 3; ++i) { const unsigned w[4] = {st[i].x, st[i].y, st[i].z, st[i].w}; float* d = L + (tid + i * NT) * 8;
      *(float4*)d = make_float4(bf2f(w[0] & 0xffff), bf2f(w[0] >> 16), bf2f(w[1] & 0xffff), bf2f(w[1] >> 16));
      *(float4*)(d + 4) = make_float4(bf2f(w[2] & 0xffff), bf2f(w[2] >> 16), bf2f(w[3] & 0xffff), bf2f(w[3] >> 16)); }
    __syncthreads();
    if (ch + 1 < nch) _Pragma("unroll") for (int i = 0; i < 3; ++i) st[i] = *(const uint4*)(RW + (long)(ch + 1) * 32 * 384 + (long)(tid + i * NT) * 8);
    for (int s = 0; s < 32; ++s) {
      const float* q = L + s * 384;
      const float4 d4 = *(const float4*)(q + col0), k4 = *(const float4*)(q + 64 + col0), kk4 = *(const float4*)(q + 128 + col0),
                   ka4 = *(const float4*)(q + 192 + col0), r4 = *(const float4*)(q + 256 + col0);
      const float2 v2 = *(const float2*)(q + 320 + row0);
      const float w0 = 1.f - d4.x, w1 = 1.f - d4.y, w2 = 1.f - d4.z, w3 = 1.f - d4.w;
      float yv[2];
      _Pragma("unroll") for (int rr = 0; rr < 2; ++rr) {
        const float vv = rr ? v2.y : v2.x;
        float sa = S[rr][0] * kk4.x + S[rr][1] * kk4.y + S[rr][2] * kk4.z + S[rr][3] * kk4.w;
        const float b0 = S[rr][0] * w0 + vv * k4.x, b1 = S[rr][1] * w1 + vv * k4.y, b2 = S[rr][2] * w2 + vv * k4.z, b3 = S[rr][3] * w3 + vv * k4.w;
        sa = allred16(sa);
        S[rr][0] = b0 + sa * ka4.x; S[rr][1] = b1 + sa * ka4.y; S[rr][2] = b2 + sa * ka4.z; S[rr][3] = b3 + sa * ka4.w;
        float y = S[rr][0] * r4.x + S[rr][1] * r4.y + S[rr][2] * r4.z + S[rr][3] * r4.w;
        yv[rr] = allred16(y);
      }
      if (cgi == 0) *(unsigned*)(Y + (long)(ch * 32 + s) * 384 + row0) = pack2(yv[0], yv[1]);
    }
  }
  float* so = p.out + (samp ? O_RWS : O_RWP) + ((size_t)(layer * (samp ? 16 : 8) + b) * 6 + h) * 4096;
  _Pragma("unroll") for (int rr = 0; rr < 2; ++rr) *(float4*)(so + (row0 + rr) * 64 + col0) = make_float4(S[rr][0], S[rr][1], S[rr][2], S[rr][3]);
  __syncthreads();
}

DI void s5_unit(const Params& pin, int layer, int samp, int unit, char* shm) {
  const Params p = relaunder(pin);
  const int tid = ltid(p), wave = tid >> 6, lane = tid & 63;
  const int T = samp ? TS : SP; const int b = unit >> 1, g = (unit & 1) * 8 + wave;
  const int gp = (layer * 16 + g) * 64 + lane;
  const float lre = p.in[I_LRE][gp], lim = p.in[I_LIM][gp];
  const float dt = expf(p.in[I_LDT][layer * 16 + g]);
  const float ang = lim * dt;
  const float sn = sinf(ang), cs = cosf(ang);
  const float mag = expf(lre * dt);
  const float lr = mag * cs, li = mag * sn;
  const float nr = lr - 1.f, ni = li, den = lre * lre + lim * lim;
  const float cr_ = (nr * lre + ni * lim) / den, ci_ = (ni * lre - nr * lim) / den;
  float Br[16], Bi[16];
  { const float* bre = p.in[I_BRE] + (size_t)gp * 16, *bim = p.in[I_BIM] + (size_t)gp * 16;
    _Pragma("unroll") for (int c = 0; c < 16; ++c) { const float br = bre[c], bi = bim[c]; Br[c] = cr_ * br - ci_ * bi; Bi[c] = cr_ * bi + ci_ * br; } }
  bf16x8 Cf[4];
  { const int n = lane & 15, kg = lane >> 4;
    const float* cre = p.in[I_CRE] + ((size_t)(layer * 16 + g) * 16 + n) * 64, *cim = p.in[I_CIM] + ((size_t)(layer * 16 + g) * 16 + n) * 64;
    _Pragma("unroll") for (int s = 0; s < 4; ++s) _Pragma("unroll") for (int j = 0; j < 8; ++j) { int k = 32 * s + 8 * kg + j;
      float v = (k < 64) ? cre[k] : -cim[k - 64]; Cf[s][j] = (short)f2bf(v); } }
  const float Dd = p.in[I_S5D][layer * 256 + g * 16 + (lane & 15)];
  float xr = 0.f, xi = 0.f;
  if (samp) { const float* s0 = p.in[I_SS5] + ((size_t)(layer * 16 + b) * 16 + g) * 128 + lane * 2; xr = s0[0]; xi = s0[1]; }
  char* wsm = shm + wave * 6144;
  float* ut = (float*)wsm; bfu* xt = (bfu*)(wsm + 1024);
  bfu* U = (bfu*)(p.ws + (samp ? S_U : P_U)) + (long)b * T * 256 + g * 16;
  uint4 un = make_uint4(0, 0, 0, 0);
  if (lane < 32) un = *(const uint4*)(U + (long)(lane >> 1) * 256 + (lane & 1) * 8);
  for (int t0 = 0; t0 < T; t0 += 16) {
    if (lane < 32) { const unsigned w[4] = {un.x, un.y, un.z, un.w}; float* d = ut + (lane >> 1) * 16 + (lane & 1) * 8;
      *(float4*)d = make_float4(bf2f(w[0] & 0xffff), bf2f(w[0] >> 16), bf2f(w[1] & 0xffff), bf2f(w[1] >> 16));
      *(float4*)(d + 4) = make_float4(bf2f(w[2] & 0xffff), bf2f(w[2] >> 16), bf2f(w[3] & 0xffff), bf2f(w[3] >> 16)); }
    if (t0 + 16 < T && lane < 32) un = *(const uint4*)(U + (long)(t0 + 16 + (lane >> 1)) * 256 + (lane & 1) * 8);
    __builtin_amdgcn_fence(__ATOMIC_RELEASE, "wavefront"); __builtin_amdgcn_wave_barrier(); __builtin_amdgcn_fence(__ATOMIC_ACQUIRE, "wavefront");
    for (int tt = 0; tt < 16; ++tt) {
      const float4* up = (const float4*)(ut + tt * 16);
      const float4 u0 = up[0], u1 = up[1], u2 = up[2], u3 = up[3];
      const float u[16] = {u0.x, u0.y, u0.z, u0.w, u1.x, u1.y, u1.z, u1.w, u2.x, u2.y, u2.z, u2.w, u3.x, u3.y, u3.z, u3.w};
      float br = 0.f, bi = 0.f;
      _Pragma("unroll") for (int c = 0; c < 16; ++c) { br += Br[c] * u[c]; bi += Bi[c] * u[c]; }
      const float nxr = lr * xr - li * xi + br, nxi = lr * xi + li * xr + bi;
      xr = nxr; xi = nxi;
      xt[tt * 136 + lane] = f2bf(xr); xt[tt * 136 + 64 + lane] = f2bf(xi);
    }
    __builtin_amdgcn_fence(__ATOMIC_RELEASE, "wavefront"); __builtin_amdgcn_wave_barrier(); __builtin_amdgcn_fence(__ATOMIC_ACQUIRE, "wavefront");
    f32x4 acc = {0.f, 0.f, 0.f, 0.f};
    { const int row = lane & 15, kg = lane >> 4;
      _Pragma("unroll") for (int s = 0; s < 4; ++s) { bf16x8 a = *(const bf16x8*)(xt + row * 136 + 32 * s + 8 * kg);
        acc = __builtin_amdgcn_mfma_f32_16x16x32_bf16(a, Cf[s], acc, 0, 0, 0); } }
    { const int ch = lane & 15, tq = lane >> 4;
      _Pragma("unroll") for (int r = 0; r < 4; ++r) { const int tk = tq * 4 + r;
        float y = acc[r] + Dd * ut[tk * 16 + ch];
        float z = 0.5f * y * (1.f + tanhf_(0.7978845608028654f * (y + 0.044715f * y * y * y)));
        U[(long)(t0 + tk) * 256 + ch] = f2bf(z); } }
    __builtin_amdgcn_fence(__ATOMIC_RELEASE, "wavefront"); __builtin_amdgcn_wave_barrier(); __builtin_amdgcn_fence(__ATOMIC_ACQUIRE, "wavefront");
  }
  float* so = p.out + (samp ? O_S5S : O_S5P) + ((size_t)(layer * (samp ? 16 : 8) + b) * 16 + g) * 128 + lane * 2;
  so[0] = xr; so[1] = xi;
}

template <int DQK, int DV>
struct Attn {
  static constexpr int PK = DQK * 2 + 16, PV = 144;
  static constexpr int KT_BYTES = 64 * PK, VT_BYTES = DV * PV, BUF = KT_BYTES + VT_BYTES;
  static constexpr int NCK = 64 * DQK / 8, NCV = DV * 8, NC = NCK + NCV, NLD = (NC + NT - 1) / NT;
  static_assert(NLD <= 5, "NLD");
  static constexpr int NS = DQK / 16, NMT = DV / 32;
  static_assert(2 * BUF + 49152 <= SHM_MAIN, "attn LDS");


  struct St { uint4 a0, a1, a2, a3, a4; };
  template <int I> static DI void g1(uint4& s, const bfu* Kbase, const bfu* Vtbase, long Tstride, int tile, const int tid) {
    if constexpr (I < NLD) { const int c = tid + I * NT;
      if (c < NCK) s = *(const uint4*)(Kbase + (long)tile * 64 * DQK + (long)c * 8);
      else if (c < NC) { const int cv = c - NCK, d = cv >> 3, part = cv & 7; s = *(const uint4*)(Vtbase + (long)d * Tstride + (long)tile * 64 + part * 8); } }
  }
  template <int I> static DI void s1(const uint4& s, char* base, const int tid) {
    if constexpr (I < NLD) { const int c = tid + I * NT;
      if (c < NCK) { const int row = c / (DQK / 8), col = c % (DQK / 8); *(uint4*)(base + row * PK + col * 16) = s; }
      else if (c < NC) { const int cv = c - NCK, d = cv >> 3, part = cv & 7; *(uint4*)(base + KT_BYTES + d * PV + part * 16) = s; } }
  }
  static DI void gload(St& st, const bfu* Kbase, const bfu* Vtbase, long Tstride, int tile, const int tid) {
    g1<0>(st.a0, Kbase, Vtbase, Tstride, tile, tid); g1<1>(st.a1, Kbase, Vtbase, Tstride, tile, tid); g1<2>(st.a2, Kbase, Vtbase, Tstride, tile, tid);
    g1<3>(st.a3, Kbase, Vtbase, Tstride, tile, tid); g1<4>(st.a4, Kbase, Vtbase, Tstride, tile, tid);
  }
  static DI void lstore(const St& st, char* shm, int buf, const int tid) {
    char* base = shm + buf * BUF;
    s1<0>(st.a0, base, tid); s1<1>(st.a1, base, tid); s1<2>(st.a2, base, tid); s1<3>(st.a3, base, tid); s1<4>(st.a4, base, tid);
  }
  static DI void run(const bfu* Kbase, const bfu* Vtbase, long Tstride, int ntiles_unit, int my_ntiles, int key_limit,
                     const bfu* qptr  , char* shm, f32x16 (&O)[NMT], float& lsum, const int tid) {
    const int lane = tid & 63, ln = lane & 31, hh = lane >> 5;
    bf16x8 qf[NS];
    if (my_ntiles > 0) _Pragma("unroll") for (int s = 0; s < NS; ++s) qf[s] = *(const bf16x8*)(qptr + s * 16 + hh * 8);
    else _Pragma("unroll") for (int s = 0; s < NS; ++s) qf[s] = bf16x8{0, 0, 0, 0, 0, 0, 0, 0};
    _Pragma("unroll") for (int mt = 0; mt < NMT; ++mt) _Pragma("unroll") for (int r = 0; r < 16; ++r) O[mt][r] = 0.f;
    float mrun = -1e30f, l = 0.f;
    St st; st.a0 = st.a1 = st.a2 = st.a3 = st.a4 = make_uint4(0, 0, 0, 0);
    gload(st, Kbase, Vtbase, Tstride, 0, tid); lstore(st, shm, 0, tid); __syncthreads();
    for (int kt = 0; kt < ntiles_unit; ++kt) {
      if (kt + 1 < ntiles_unit) gload(st, Kbase, Vtbase, Tstride, kt + 1, tid);
      if (kt < my_ntiles) {
        const char* kb = shm + (kt & 1) * BUF; const char* vb = kb + KT_BYTES;
        f32x16 s[2];
        _Pragma("unroll") for (int k2 = 0; k2 < 2; ++k2) {
          _Pragma("unroll") for (int r = 0; r < 16; ++r) s[k2][r] = 0.f;
          _Pragma("unroll") for (int si = 0; si < NS; ++si) {
            bf16x8 a = *(const bf16x8*)(kb + (k2 * 32 + ln) * PK + (si * 16 + hh * 8) * 2);
            s[k2] = __builtin_amdgcn_mfma_f32_32x32x16_bf16(a, qf[si], s[k2], 0, 0, 0);
          }
        }
        if ((kt + 1) * 64 > key_limit) {
          _Pragma("unroll") for (int k2 = 0; k2 < 2; ++k2) _Pragma("unroll") for (int r = 0; r < 16; ++r) { int key = kt * 64 + k2 * 32 + crow(r, hh); if (key >= key_limit) s[k2][r] = -1e30f; }
        }
        float mx = -1e30f;
        _Pragma("unroll") for (int k2 = 0; k2 < 2; ++k2) _Pragma("unroll") for (int r = 0; r < 16; ++r) mx = fmaxf(mx, s[k2][r]);
        mx = fmaxf(mx, __shfl_xor(mx, 32));
        const float mnew = fmaxf(mrun, mx);
        const float corr = __builtin_amdgcn_exp2f(mrun - mnew);
        mrun = mnew; l *= corr;
        _Pragma("unroll") for (int mt = 0; mt < NMT; ++mt) _Pragma("unroll") for (int r = 0; r < 16; ++r) O[mt][r] *= corr;
        _Pragma("unroll") for (int k2 = 0; k2 < 2; ++k2) _Pragma("unroll") for (int r = 0; r < 16; ++r) { float pv = __builtin_amdgcn_exp2f(s[k2][r] - mnew); l += pv; s[k2][r] = pv; }
        _Pragma("unroll") for (int k2 = 0; k2 < 2; ++k2) _Pragma("unroll") for (int sp = 0; sp < 2; ++sp) {
          bf16x8 pf;
          _Pragma("unroll") for (int j = 0; j < 8; ++j) pf[j] = (short)f2bf(s[k2][8 * sp + j]);
          _Pragma("unroll") for (int mt = 0; mt < NMT; ++mt) {
            const char* vp = vb + (mt * 32 + ln) * PV + (k2 * 32 + sp * 16 + hh * 4) * 2;
            s16x4 lo = *(const s16x4*)vp, hi = *(const s16x4*)(vp + 16);
            bf16x8 vf = __builtin_shufflevector(lo, hi, 0, 1, 2, 3, 4, 5, 6, 7);
            O[mt] = __builtin_amdgcn_mfma_f32_32x32x16_bf16(vf, pf, O[mt], 0, 0, 0);
          }
        }
      }
      if (kt + 1 < ntiles_unit) lstore(st, shm, (kt + 1) & 1, tid);
      __syncthreads();
    }
    lsum = l + __shfl_xor(l, 32);
  }
};

DI void attn_prompt_unit(const Params& pin, int unit, char* shm) {
  const Params p = relaunder(pin);
  const int qb = 31 - unit / 48, bh = unit % 48, b = bh / 6, h = bh % 6;
  const int tidu = ltid(p);
  const int wave = tidu >> 6, lane = tidu & 63, ln = lane & 31, hh = lane >> 5;
  const int q0 = qb * 256 + wave * 32;
  const bfu* Kb = (const bfu*)(p.ws + P_KB) + (long)bh * SP * 96;
  const bfu* Vt = (const bfu*)(p.ws + P_VT) + (long)bh * 64 * SP;
  const bfu* Q = (const bfu*)(p.ws + P_Q) + ((long)b * SP + q0 + ln) * 576 + h * 96;
  f32x16 O[2]; float lsum;
  Attn<96, 64>::run(Kb, Vt, SP, qb * 4 + 4, q0 / 64 + 1, 1 << 30, Q, shm, O, lsum, tidu);
  const float inv = 1.f / lsum;
  bfu* MG = (bfu*)(p.ws + P_MERGED) + ((long)b * SP + q0 + ln) * 1024 + h * 64;
  _Pragma("unroll") for (int mt = 0; mt < 2; ++mt) _Pragma("unroll") for (int g = 0; g < 4; ++g) {
    const int d0 = mt * 32 + 8 * g + 4 * hh;
    *(uint2*)(MG + d0) = make_uint2(pack2(O[mt][4 * g] * inv, O[mt][4 * g + 1] * inv), pack2(O[mt][4 * g + 2] * inv, O[mt][4 * g + 3] * inv));
  }
}

DI void attn_sample_unit(const Params& pin, int layer, int b, char* shm) {
  const Params p = relaunder(pin);
  const int tid = ltid(p), wave = tid >> 6, lane = tid & 63, ln = lane & 31, hh = lane >> 5;
  const bfu* Qs = (const bfu*)(p.ws + S_Q);
  bfu* QA = (bfu*)(p.ws + S_QABS);
  const float* WK = p.in[I_WKVB] + (size_t)layer * 128 * 768;
  for (int it = tid; it < 768; it += NT) {
    const int h = it >> 7, c = it & 127;
    float wcol[64];
    _Pragma("unroll") for (int d = 0; d < 64; d += 4) { float4 v = *(const float4*)(WK + c * 768 + h * 128 + d); wcol[d] = v.x; wcol[d + 1] = v.y; wcol[d + 2] = v.z; wcol[d + 3] = v.w; }
    for (int row = 0; row < 32; ++row) {
      const bfu* q = Qs + (long)(b * 32 + row) * 576 + h * 96;
      float acc = 0.f;
      _Pragma("unroll") for (int d = 0; d < 64; ++d) acc += bf2f(q[d]) * wcol[d];
      QA[((long)(b * 6 + h) * 32 + row) * 160 + c] = f2bf(acc);
    }
  }
  for (int e = tid; e < 6 * 32 * 32; e += NT) { const int h = e >> 10, row = (e >> 5) & 31, c = e & 31;
    QA[((long)(b * 6 + h) * 32 + row) * 160 + 128 + c] = Qs[(long)(b * 32 + row) * 576 + h * 96 + 64 + c]; }
  __threadfence(); __syncthreads();
  const bfu* Kc = (const bfu*)(p.ws + S_KCAT) + (long)b * SKP * 160;
  const bfu* Vt = (const bfu*)(p.ws + S_VT) + (long)b * 128 * SKP;
  const int hw = wave < 6 ? wave : 0;
  const bfu* Q = QA + ((long)(b * 6 + hw) * 32 + ln) * 160;
  bfu* stash = (bfu*)(shm + 2 * Attn<160, 64>::BUF);
  for (int half = 0; half < 2; ++half) {
    f32x16 O[2]; float lsum;
    Attn<160, 64>::run(Kc, Vt + (long)half * 64 * SKP, SKP, 65, wave < 6 ? 65 : 0, SKS, Q, shm, O, lsum, tid);
    if (wave < 6) { const float inv = 1.f / lsum;
      _Pragma("unroll") for (int mt = 0; mt < 2; ++mt) _Pragma("unroll") for (int r = 0; r < 16; ++r)
        stash[half * 12288 + (wave * 32 + ln) * 64 + mt * 32 + crow(r, hh)] = f2bf(O[mt][r] * inv); }
    __syncthreads();
  }
  if (wave < 6) {
    const int h = wave, c = lane;
    float acc[32];
    _Pragma("unroll") for (int r = 0; r < 32; ++r) acc[r] = 0.f;
    for (int d = 0; d < 128; ++d) { const float w = WK[d * 768 + h * 128 + 64 + c];
      const bfu* o = stash + (d >> 6) * 12288 + h * 32 * 64 + (d & 63);
      _Pragma("unroll") for (int r = 0; r < 32; ++r) acc[r] += bf2f(o[r * 64]) * w; }
    bfu* MG = (bfu*)(p.ws + S_MERGED);
    _Pragma("unroll") for (int r = 0; r < 32; ++r) MG[(long)(b * 32 + r) * 1024 + h * 64 + c] = f2bf(acc[r]);
  }
  __syncthreads();
}

DI void rwkv_post(const Params& pin, int layer) {
  const Params p = relaunder(pin);
  const int tidw = ltid(p); const int wave = tidw >> 6, lane = tidw & 63;
  const long total = (long)(MP + MS) * 6;
  for (long u = (long)blockIdx.x * 8 + wave; u < total; u += (long)gridDim.x * 8) {
    const int samp = u >= (long)MP * 6; const long uu = samp ? u - (long)MP * 6 : u;
    const long r = uu / 6; const int h = (int)(uu % 6); const int T = samp ? TS : SP;
    const long b = r / T, t = r % T; const int c = h * 64 + lane;
    const bfu* Y = (const bfu*)(p.ws + (samp ? S_Y : P_Y)); const bfu* G = (const bfu*)(p.ws + (samp ? S_G : P_G));
    const float* BON = (const float*)(p.ws + (samp ? S_BON : P_BON)); const bfu* RW = (const bfu*)(p.ws + (samp ? S_RW : P_RW));
    const float y = bf2f(Y[r * 384 + c]);
    const float mu = wave_sum(y) * (1.f / 64);
    const float dv = y - mu;
    const float var = wave_sum(dv * dv) * (1.f / 64);
    const float v = bf2f(RW[((b * 6 + h) * T + t) * 384 + 320 + lane]);
    float o = dv * rsqrtf(var + 64e-5f) * p.in[I_GNG][layer * 384 + c] + p.in[I_GNB][layer * 384 + c];
    o = (o + BON[r * 6 + h] * v) * bf2f(G[r * 384 + c]);
    bfu* MG = (bfu*)(p.ws + (samp ? S_MERGED : P_MERGED));
    MG[r * 1024 + 640 + c] = f2bf(o);
  }
}

DI void run_phase(const Params& p, int ph, char* shm) {
  if (ph == 0) { U_INIT(phase_init(p, shm)); return; }
  const int layer = (ph - 1) / 9, sub = (ph - 1) % 9;
  const int bid = blockIdx.x, G = gridDim.x;
  int nj = 0, k0 = 0, k1 = 0, k2 = 0, s0 = 0, s1 = 1, s2 = 0, n0 = 0, n1 = 0, n2 = 0;
  if (sub == 0) { nj = 2; k0 = k1 = K_PROJ; n0 = 2048; n1 = 16; }
  else if (sub == 1) { nj = 3; k0 = k1 = K_Q; k2 = K_KV; n0 = 768; n1 = 6; n2 = 768; }
  else if (sub == 3) { nj = 2; k0 = k1 = K_GLU; n0 = 256; n1 = 2; }
  else if (sub == 4) { nj = 2; k0 = k1 = K_RES1; n0 = 1024; n1 = 8; }
  else if (sub == 6) { nj = 2; k0 = k1 = K_UP; n0 = 4096; n1 = 32; }
  else if (sub == 7) { nj = 2; k0 = k1 = K_RES2; n0 = 1024; n1 = 8; }
  if (nj > 0) {
    const int tot = n0 + n1 + n2;
    for (int t = bid; t < tot; t += G) {
      int kind, samp, lt;
      if (t < n0) { kind = k0; samp = s0; lt = t; } else if (t < n0 + n1) { kind = k1; samp = s1; lt = t - n0; } else { kind = k2; samp = s2; lt = t - n0 - n1; }
      const Job j = get_job(p, kind, layer, samp);
      U_GEMM(gemm_do_tile(p, j, layer, lt, shm));
    }
  }
  if (sub == 1) {
    const int nrp = 2048, nrs = 16, nmp = 1024, nms = 8, ncc = 1024;
    const int e3 = nrp, e4 = e3 + nrs, e5 = e4 + nmp, e6 = e5 + nms, e7 = e6 + ncc;
    for (int t = bid; t < e7; t += G) {
      if (t < e4) U_RP(rwkv_prep_unit(p, layer, t >= e3, t < e3 ? t : t - e3, shm));
      else if (t < e6) mla_prep_unit(p, layer, t >= e5, t < e5 ? t - e4 : t - e5);
      else U_CC(cache_conv_unit(p, layer, t - e6, shm));
    }
  } else if (sub == 2) {
    unsigned* ctr = (unsigned*)(p.ws + OFF_CTL) + layer;
    int* su = (int*)(shm + SHM_MAIN + 1024);
    const int total = 48 + 16 + 16 + 1536 + 96 + 32;
    while (true) {
      if (ltid(p) == 0) *su = (int)atomicAdd(ctr, 1u);
      __syncthreads();
      const int u = *su;
      __syncthreads();
      if (u >= total) break;
      if (u < 48 || (u >= 1616 && u < 1712)) U_SCAN(rwkv_scan_unit(p, layer, u >= 48, u < 48 ? u : u - 1616, shm));
      else if (u < 64 || u >= 1712) U_S5(s5_unit(p, layer, u >= 64, u < 64 ? u - 48 : u - 1712, shm));
      else if (u < 80) U_AS(attn_sample_unit(p, layer, u - 64, shm));
      else U_AP(attn_prompt_unit(p, u - 80, shm));
      __syncthreads();
    }
  } else if (sub == 3) {
    rwkv_post(p, layer);
  } else if (sub == 5) {
    ln_rows(p, layer, 0, 0);
  } else if (sub == 8) {
    ln_rows(p, layer, 1, layer == 1);
  }
}

constexpr int NPHASE = 19;

__global__ void __launch_bounds__(NT) mega(Params p, int ph_lo, int ph_hi) {
  __shared__ __attribute__((aligned(16))) char shm[SHM_BYTES];
  p.wave = __builtin_amdgcn_readfirstlane((int)(threadIdx.x >> 6));
#if MULTI
  for (int ph = ph_lo; ph < ph_hi; ++ph) run_phase(p, ph, shm);
#else
  cg::grid_group grid = cg::this_grid();
  for (int ph = ph_lo; ph < ph_hi; ++ph) { run_phase(p, ph, shm); if (ph + 1 < ph_hi) grid.sync(); }
#endif
}

extern "C" void kernel_launch(void* const* d_in, const int* in_sizes, int n_in, void* d_out, int out_size, void* d_ws, size_t ws_size,
                              hipStream_t stream) {
  Params p{};
  _Pragma("unroll") for (int i = 0; i < 40; ++i) p.in[i] = (const float*)d_in[i];
  p.out = (float*)d_out; p.ws = (char*)d_ws;
  if (ws_size < WS_NEED) { fprintf(stderr, "workspace too small: %zu < %zu\n", ws_size, (size_t)WS_NEED); return; }
#if MULTI
  for (int ph = 0; ph < NPHASE; ++ph) {
    hipLaunchKernelGGL(mega, dim3(256), dim3(NT), 0, stream, p, ph, ph + 1);
  }
#else
  static int grid_blocks = 0;
  if (!grid_blocks) {
    int dev = 0, cus = 0, per_cu = 0;
    hipGetDevice(&dev);
    hipDeviceGetAttribute(&cus, hipDeviceAttributeMultiprocessorCount, dev);
    hipOccupancyMaxActiveBlocksPerMultiprocessor(&per_cu, mega, NT, 0);
    if (per_cu > 1) per_cu = 1;
    grid_blocks = cus * per_cu;
  }
  int lo = 0, hi = NPHASE;
  void* args[] = {&p, &lo, &hi};
  hipError_t e = hipLaunchCooperativeKernel((void*)mega, dim3(grid_blocks), dim3(NT), args, 0, stream);
  if (e != hipSuccess) fprintf(stderr, "cooperative launch failed: %s (grid %d)\n", hipGetErrorString(e), grid_blocks);
#endif
}
```

```cpp
#include <hip/hip_runtime.h>
#include <hip/hip_cooperative_groups.h>
#include <stdint.h>
#include <cstdio>
namespace cg = cooperative_groups;

#ifndef MULTI
#define MULTI 0
#endif

#ifdef NO_SCAN
#define U_SCAN(x) do{}while(0)
#else
#define U_SCAN(x) x
#endif
#ifdef NO_S5
#define U_S5(x) do{}while(0)
#else
#define U_S5(x) x
#endif
#ifdef NO_AS
#define U_AS(x) do{}while(0)
#else
#define U_AS(x) x
#endif
#ifdef NO_AP
#define U_AP(x) do{}while(0)
#else
#define U_AP(x) x
#endif
#ifdef NO_RP
#define U_RP(x) do{}while(0)
#else
#define U_RP(x) x
#endif
#ifdef NO_GEMM
#define U_GEMM(x) do{}while(0)
#else
#define U_GEMM(x) x
#endif
#ifdef NO_INIT
#define U_INIT(x) do{}while(0)
#else
#define U_INIT(x) x
#endif
#ifdef NO_CC
#define U_CC(x) do{}while(0)
#else
#define U_CC(x) x
#endif
#define DI __device__ __forceinline__
typedef unsigned short bfu;
using bf16x8 = __attribute__((ext_vector_type(8))) short;
using s16x4  = __attribute__((ext_vector_type(4))) short;
using f32x4  = __attribute__((ext_vector_type(4))) float;
using f32x16 = __attribute__((ext_vector_type(16))) float;

constexpr int NT = 512;
constexpr int MP = 65536, MS = 512, SP = 8192, TS = 32, SKP = 4160, SKS = 4128;
constexpr float ALPHA = 1.4142135623730951f;
constexpr float QSCALE = 0.10206207261596575f * 1.4426950408889634f;
constexpr size_t MiB = 1048576;

constexpr size_t LW_WIN = 0;
constexpr size_t LW_WQB = LW_WIN + (size_t)2048 * 1024 * 2;
constexpr size_t LW_WKV = LW_WQB + 768 * 256 * 2;
constexpr size_t LW_WGLU = LW_WKV + 768 * 128 * 2;
constexpr size_t LW_WOUT = LW_WGLU + 256 * 256 * 2;
constexpr size_t LW_WUP = LW_WOUT + 1024 * 1024 * 2;
constexpr size_t LW_WDN = LW_WUP + (size_t)4096 * 1024 * 2;
constexpr size_t LW_STRIDE = 23 * MiB;
constexpr size_t OFF_X = 46 * MiB;
constexpr size_t OFF_XS = 174 * MiB;
constexpr size_t OFF_TAB = 175 * MiB;
constexpr size_t OFF_CTL = 176 * MiB;
constexpr size_t OFF_SS = 177 * MiB;
constexpr size_t OFF_P = 233 * MiB;
constexpr size_t S_QL = OFF_SS;
constexpr size_t S_KVL = S_QL + 512 * 256 * 2;
constexpr size_t S_U = S_KVL + 512 * 160 * 2;
constexpr size_t S_PR = S_U + 512 * 256 * 2;
constexpr size_t S_Q = S_PR + 512 * 1280 * 2;
constexpr size_t S_QABS = S_Q + 512 * 576 * 2;
constexpr size_t S_RW = S_QABS + 16 * 6 * 32 * 160 * 2;
constexpr size_t S_G = S_RW + 16 * 6 * 32 * 384 * 2;
constexpr size_t S_BON = S_G + 512 * 384 * 2;
constexpr size_t S_Y = S_BON + 512 * 6 * 4;
constexpr size_t S_MERGED = S_Y + 512 * 384 * 2;
constexpr size_t S_Z = S_MERGED + 512 * 1024 * 2;
constexpr size_t S_HID = S_Z + 512 * 1024 * 4;
constexpr size_t S_KCAT = S_HID + 512 * 4096 * 2;
constexpr size_t S_VT = S_KCAT + (size_t)16 * SKP * 160 * 2;
constexpr size_t S_ZS5 = S_VT + (size_t)16 * 128 * SKP * 2;
constexpr size_t S_END = S_ZS5 + 512 * 256 * 2;
static_assert(S_END <= OFF_P, "sample scratch overflow");
constexpr size_t P_QL = OFF_P;
constexpr size_t P_KVL = OFF_P + 32 * MiB;
constexpr size_t P_PR = OFF_P + 52 * MiB;
constexpr size_t P_U = OFF_P + 212 * MiB;
constexpr size_t P_Q = OFF_P + 244 * MiB;
constexpr size_t P_KB = OFF_P + 316 * MiB;
constexpr size_t P_VT = OFF_P + 388 * MiB;
constexpr size_t P_RW = OFF_P + 436 * MiB;
constexpr size_t P_G = OFF_P + 724 * MiB;
constexpr size_t P_BON = OFF_P + 772 * MiB;
constexpr size_t P_MERGED = OFF_P;
constexpr size_t P_Y = OFF_P + 128 * MiB;
constexpr size_t P_ZS5 = OFF_P + 176 * MiB;
constexpr size_t P_Z1 = OFF_P + 212 * MiB;
constexpr size_t P_HID = OFF_P;
constexpr size_t P_Z2 = OFF_P + 512 * MiB;
constexpr size_t WS_NEED = OFF_P + 774 * MiB;

constexpr size_t O_YP = 0;
constexpr size_t O_YS = 67108864;
constexpr size_t O_CKVP = O_YS + 524288;
constexpr size_t O_KRP = O_CKVP + 16777216;
constexpr size_t O_S5P = O_KRP + 4194304;
constexpr size_t O_RWP = O_S5P + 32768;
constexpr size_t O_SHP = O_RWP + 393216;
constexpr size_t O_CKVS = O_SHP + 20480;
constexpr size_t O_KRS = O_CKVS + 131072;
constexpr size_t O_S5S = O_KRS + 32768;
constexpr size_t O_RWS = O_S5S + 65536;
constexpr size_t O_SHS = O_RWS + 786432;

enum { I_XP = 0, I_XS, I_CCKV, I_CKR, I_SS5, I_SRW, I_SSH, I_WIN, I_QG, I_WQB, I_KVG, I_WKVB, I_LRE, I_LIM, I_LDT, I_BRE, I_BIM,
       I_CRE, I_CIM, I_S5D, I_WGLU, I_BGLU, I_MU, I_W0, I_WW2, I_A0, I_WA2, I_WG2, I_KK, I_KA, I_RK, I_GNG, I_GNB, I_WOUT,
       I_LN1G, I_LN1B, I_WUP, I_WDN, I_LN2G, I_LN2B };

struct Params { const float* in[40]; float* out; char* ws; int wave; int pad_; };
DI int opaque0() { int z; asm volatile("s_mov_b32 %0, 0" : "=s"(z)); return z; }
DI int lane_id() { return (int)__builtin_amdgcn_mbcnt_hi(~0u, __builtin_amdgcn_mbcnt_lo(~0u, 0u)); }
DI int ltid(const Params& p) { return p.wave * 64 + lane_id(); }
DI Params relaunder(const Params& p) {
  Params q; const int z = opaque0();
  _Pragma("unroll") for (int i = 0; i < 40; ++i) q.in[i] = p.in[i] + z;
  q.out = p.out + z; q.ws = p.ws + z; q.wave = p.wave + z; q.pad_ = 0; return q;
}


constexpr int SHM_MAIN = 131072;
constexpr int SHM_BYTES = SHM_MAIN + 2048;

DI float bf2f(bfu x) { return __uint_as_float(((unsigned)x) << 16); }
DI bfu f2bf(float f) { __bf16 b = (__bf16)f; return __builtin_bit_cast(unsigned short, b); }
DI unsigned pack2(float a, float b) { return (unsigned)f2bf(a) | ((unsigned)f2bf(b) << 16); }

template <int CTRL> DI float dppf(float x) { return __int_as_float(__builtin_amdgcn_update_dpp(0, __float_as_int(x), CTRL, 0xF, 0xF, false)); }
DI float allred16(float x) { x += dppf<0x128>(x); x += dppf<0x124>(x); x += dppf<0x122>(x); x += dppf<0x121>(x); return x; }
DI float wave_sum(float v) {
  v = allred16(v);
  const int iv = __float_as_int(v);
  return __int_as_float(__builtin_amdgcn_readlane(iv, 0)) + __int_as_float(__builtin_amdgcn_readlane(iv, 16)) +
         __int_as_float(__builtin_amdgcn_readlane(iv, 32)) + __int_as_float(__builtin_amdgcn_readlane(iv, 48));
}
DI float sigmoidf_(float x) { return 1.f / (1.f + __expf(-x)); }
DI float tanhf_(float x) { return 1.f - 2.f / (__expf(2.f * x) + 1.f); }
DI int crow(int reg, int h) { return (reg & 3) + 8 * (reg >> 2) + 4 * h; }

DI void tr_weight(const float* src, int K, int N, int Np, const float* scale, bfu* dst, char* shm, const int tid) {
  float* tile = (float*)shm;
  const int ntk = K / 64, ntn = Np / 64;
  for (int t = blockIdx.x; t < ntk * ntn; t += gridDim.x) {
    const int k0 = (t % ntk) * 64, n0 = (t / ntk) * 64;
    for (int e = tid; e < 4096; e += NT) {
      int r = e >> 6, c = e & 63;
      float v = 0.f;
      if (n0 + c < N) { v = src[(long)(k0 + r) * N + n0 + c]; if (scale) v *= scale[k0 + r]; }
      tile[r * 65 + c] = v;
    }
    __syncthreads();
    for (int e = tid; e < 4096; e += NT) {
      int rn = e >> 6, ck = e & 63;
      dst[(long)(n0 + rn) * K + k0 + ck] = f2bf(tile[ck * 65 + rn]);
    }
    __syncthreads();
  }
}

DI void phase_init(const Params& pin, char* shm) {
  const Params p = relaunder(pin);
  const int tid = ltid(p);
  const long gtid = (long)blockIdx.x * NT + tid, gsz = (long)gridDim.x * NT;
  if (blockIdx.x == 0) for (int i = tid; i < 1024; i += NT) ((unsigned*)(p.ws + OFF_CTL))[i] = 0u;
  float2* tab = (float2*)(p.ws + OFF_TAB);
  for (long i = gtid; i < 8192 * 16; i += gsz) {
    int pos = (int)(i >> 4), k = (int)(i & 15);
    const float inv = exp2f(-(float)k * 0.8304820237218406f);
    const float ang = (float)pos * inv;
    const float s = sinf(ang), c = cosf(ang);
    tab[i] = make_float2(c, s);
  }
  for (int l = 0; l < 2; ++l) {
    char* wb = p.ws + l * LW_STRIDE;
    tr_weight(p.in[I_WIN] + (size_t)l * 1024 * 1952, 1024, 1952, 2048, nullptr, (bfu*)(wb + LW_WIN), shm, tid);
    tr_weight(p.in[I_WQB] + (size_t)l * 256 * 576, 256, 576, 768, p.in[I_QG] + l * 256, (bfu*)(wb + LW_WQB), shm, tid);
    tr_weight(p.in[I_WKVB] + (size_t)l * 128 * 768, 128, 768, 768, p.in[I_KVG] + l * 128, (bfu*)(wb + LW_WKV), shm, tid);
    tr_weight(p.in[I_WGLU] + (size_t)l * 256 * 256, 256, 256, 256, nullptr, (bfu*)(wb + LW_WGLU), shm, tid);
    tr_weight(p.in[I_WOUT] + (size_t)l * 1024 * 1024, 1024, 1024, 1024, nullptr, (bfu*)(wb + LW_WOUT), shm, tid);
    tr_weight(p.in[I_WUP] + (size_t)l * 1024 * 4096, 1024, 4096, 4096, nullptr, (bfu*)(wb + LW_WUP), shm, tid);
    tr_weight(p.in[I_WDN] + (size_t)l * 4096 * 1024, 4096, 1024, 1024, nullptr, (bfu*)(wb + LW_WDN), shm, tid);
  }
  {
    const float4* xp = (const float4*)p.in[I_XP]; uint2* X = (uint2*)(p.ws + OFF_X);
    for (long i = gtid; i < (long)MP * 256; i += gsz) { float4 v = xp[i]; X[i] = make_uint2(pack2(v.x, v.y), pack2(v.z, v.w)); }
    const float4* xs = (const float4*)p.in[I_XS]; uint2* XS = (uint2*)(p.ws + OFF_XS);
    for (long i = gtid; i < (long)MS * 256; i += gsz) { float4 v = xs[i]; XS[i] = make_uint2(pack2(v.x, v.y), pack2(v.z, v.w)); }
  }
}

constexpr int BM = 256, BK = 64, HALF = 128, NXCD = 8, WGM = 8, HT = HALF * BK;
DI int lds_byte(int r, int c) {
  int st = (r >> 4) * 2 + (c >> 5), rr = r & 15, cc = c & 31, ob = rr * 64 + cc * 2;
  return st * 1024 + (ob ^ (((ob >> 9) & 1) << 5));
}
DI void stage_rc(int b, int& R, int& C) {
  int st = b / 1024, sb = b % 1024, swz = sb ^ (((sb >> 9) & 1) << 5);
  R = (st >> 1) * 16 + swz / 64; C = (st & 1) * 32 + (swz % 64) / 2;
}
enum { K_PROJ = 0, K_Q, K_KV, K_GLU, K_RES1, K_UP, K_RES2 };
struct Job { const bfu* A; const bfu* Bt; int lda, ldb, M, N, K, kind, samp; };

DI void gemm_tile(const bfu* A, const bfu* Bt, const int lda, const int ldb, const int K, const int brow, const int bcol,
                  bfu* shm, f32x4 (&acc)[2][2][4][2], const int tidg) {
#define SA(b, h) (shm + ((b) * 2 + (h)) * HT)
#define SB(b, h) (shm + (4 + (b) * 2 + (h)) * HT)
#define STAGE(P, BASE, LD, OFF, br, kt) do { const char* _gb = (const char*)((BASE) + ((long)(br) * (LD) + (long)(kt) * BK)); \
    asm volatile("" : "+s"(_gb)); \
    _Pragma("unroll") for (int _i = 0; _i < 2; ++_i) { \
      __builtin_amdgcn_global_load_lds((const unsigned*)(_gb + (long)_i * 128 * (LD) + OFF), \
        (__attribute__((address_space(3))) unsigned*)((char*)(P) + wv1024 + _i * 8192), 16, 0, 0); } } while (0)
#define LDA(dst, b, h) _Pragma("unroll") for (int m = 0; m < 4; ++m) _Pragma("unroll") for (int k = 0; k < 2; ++k) \
    dst[m][k] = *reinterpret_cast<const bf16x8*>((const char*)SA(b, h) + la + (m * 2048 + k * 1024))
#define LDB(dst, b, h) _Pragma("unroll") for (int n = 0; n < 2; ++n) _Pragma("unroll") for (int k = 0; k < 2; ++k) \
    dst[n][k] = *reinterpret_cast<const bf16x8*>((const char*)SB(b, h) + lb + (n * 2048 + k * 1024))
#define MMA(ai, bj, At, Bx) do { __builtin_amdgcn_s_setprio(1); \
    _Pragma("unroll") for (int m = 0; m < 4; ++m) _Pragma("unroll") for (int n = 0; n < 2; ++n) _Pragma("unroll") for (int k = 0; k < 2; ++k) \
      acc[ai][bj][m][n] = __builtin_amdgcn_mfma_f32_16x16x32_bf16(At[m][k], Bx[n][k], acc[ai][bj][m][n], 0, 0, 0); \
    __builtin_amdgcn_s_setprio(0); } while (0)
#define WAIT_V(n) asm volatile("s_waitcnt vmcnt(" #n ")" ::: "memory")
#define WAIT_L(n) asm volatile("s_waitcnt lgkmcnt(" #n ")" ::: "memory")
#define BAR __builtin_amdgcn_s_barrier()
#define SCHED __builtin_amdgcn_sched_barrier(0)
  const int tb16 = tidg * 16;
  const int wv1024 = __builtin_amdgcn_readfirstlane(tidg >> 6) * 1024;
  const int wid = tidg >> 6, lane = tidg & 63, wr = wid >> 2, wc = wid & 3, fr = lane & 15, fq = lane >> 4;
  _Pragma("unroll") for (int a = 0; a < 2; ++a) _Pragma("unroll") for (int b = 0; b < 2; ++b) _Pragma("unroll") for (int m = 0; m < 4; ++m) _Pragma("unroll") for (int n = 0; n < 2; ++n) acc[a][b][m][n] = f32x4{0.f, 0.f, 0.f, 0.f};
  bf16x8 At[4][2], B0[2][2], B1[2][2];
  const int nt = K / BK;
  unsigned aoff, boff;
  { int _r, _c; stage_rc(tb16, _r, _c); aoff = (unsigned)(_r * lda + _c) * 2u; boff = (unsigned)(_r * ldb + _c) * 2u; }
  const int sw_ = (fr * 64 + fq * 16) ^ ((((fr * 64 + fq * 16) >> 9) & 1) << 5);
  const int la = wr * 8192 + sw_, lb = wc * 4096 + sw_;
  STAGE(SB(0, 0), Bt, ldb, boff, bcol, 0); STAGE(SA(0, 0), A, lda, aoff, brow, 0);
  STAGE(SB(0, 1), Bt, ldb, boff, bcol + HALF, 0); STAGE(SA(0, 1), A, lda, aoff, brow + HALF, 0);
  if (wr == 1) BAR;
  WAIT_V(4); BAR;
  STAGE(SB(1, 0), Bt, ldb, boff, bcol, 1); STAGE(SA(1, 0), A, lda, aoff, brow, 1); STAGE(SB(1, 1), Bt, ldb, boff, bcol + HALF, 1);
  WAIT_V(6); BAR;
  for (int t = 0; t < nt - 2; t += 2) {
    LDB(B0, 0, 0); SCHED; LDA(At, 0, 0); STAGE(SA(1, 1), A, lda, aoff, brow + HALF, t + 1);
    WAIT_L(8); BAR; WAIT_L(0); MMA(0, 0, At, B0); BAR; SCHED;
    LDB(B1, 0, 1); STAGE(SB(0, 0), Bt, ldb, boff, bcol, t + 2);
    BAR; WAIT_L(0); MMA(0, 1, At, B1); BAR;
    LDA(At, 0, 1); STAGE(SA(0, 0), A, lda, aoff, brow, t + 2);
    BAR; WAIT_L(0); MMA(1, 0, At, B0); BAR; SCHED;
    STAGE(SB(0, 1), Bt, ldb, boff, bcol + HALF, t + 2);
    WAIT_V(6); BAR; MMA(1, 1, At, B1); BAR;
    LDB(B0, 1, 0); SCHED; LDA(At, 1, 0); STAGE(SA(0, 1), A, lda, aoff, brow + HALF, t + 2);
    WAIT_L(8); BAR; WAIT_L(0); MMA(0, 0, At, B0); BAR; SCHED;
    LDB(B1, 1, 1); STAGE(SB(1, 0), Bt, ldb, boff, bcol, t + 3);
    BAR; WAIT_L(0); MMA(0, 1, At, B1); BAR;
    LDA(At, 1, 1); STAGE(SA(1, 0), A, lda, aoff, brow, t + 3);
    BAR; WAIT_L(0); MMA(1, 0, At, B0); BAR; SCHED;
    STAGE(SB(1, 1), Bt, ldb, boff, bcol + HALF, t + 3);
    WAIT_V(6); BAR; MMA(1, 1, At, B1); BAR;
  }
  { LDB(B0, 0, 0); LDA(At, 0, 0); STAGE(SA(1, 1), A, lda, aoff, brow + HALF, nt - 1);
    BAR; WAIT_L(0); MMA(0, 0, At, B0); BAR;
    LDB(B1, 0, 1); BAR; WAIT_L(0); MMA(0, 1, At, B1); BAR;
    LDA(At, 0, 1); WAIT_V(4); BAR; WAIT_L(0); MMA(1, 0, At, B0); MMA(1, 1, At, B1); BAR; }
  { LDB(B0, 1, 0); LDA(At, 1, 0); WAIT_V(2); BAR; WAIT_L(0); MMA(0, 0, At, B0); BAR;
    LDB(B1, 1, 1); WAIT_V(0); BAR; WAIT_L(0); MMA(0, 1, At, B1); BAR;
    LDA(At, 1, 1); BAR; WAIT_L(0); MMA(1, 0, At, B0); MMA(1, 1, At, B1); BAR; }
  if (wr == 0) BAR;
}

template <class F>
DI void epi_loop(f32x4 (&acc)[2][2][4][2], int wr, int wc, int fq, F f) {
  _Pragma("unroll") for (int ai = 0; ai < 2; ++ai) _Pragma("unroll") for (int bj = 0; bj < 2; ++bj) _Pragma("unroll") for (int m = 0; m < 4; ++m)
    f(ai * 128 + wr * 64 + m * 16 + fq * 4, bj * 128 + wc * 32, acc[ai][bj][m][0], acc[ai][bj][m][1]);
}

DI f32x4 quad_tr(f32x4 v, const bool o1, const bool o2) {
  const float s0 = o1 ? v[0] : v[1], s1 = o1 ? v[2] : v[3];
  const float r0 = dppf<0xB1>(s0), r1 = dppf<0xB1>(s1);
  if (o1) { v[0] = r0; v[2] = r1; } else { v[1] = r0; v[3] = r1; }
  const float t0 = o2 ? v[0] : v[2], t1 = o2 ? v[1] : v[3];
  const float q0 = dppf<0x4E>(t0), q1 = dppf<0x4E>(t1);
  if (o2) { v[0] = q0; v[1] = q1; } else { v[2] = q0; v[3] = q1; }
  return v;
}

DI void gemm_epilogue(const Params& pin, const Job& jb, int layer, int brow, int bcol, f32x4 (&acc)[2][2][4][2], const float* rs) {
  const Params p = relaunder(pin);
  const int tide = ltid(p);
  const int wid = tide >> 6, lane = tide & 63, wr = wid >> 2, wc = wid & 3, fr = lane & 15, fq = lane >> 4;
  const int samp = jb.samp, T = samp ? TS : SP, LT = samp ? 5 : 13, kind = jb.kind;
  const bool o1 = lane & 1, o2 = lane & 2; const int fl = fr & 3, fc = fr & 12;
  char* ws = p.ws;
  if (kind == K_PROJ) {
    bfu* QL = (bfu*)(ws + (samp ? S_QL : P_QL)); bfu* KVL = (bfu*)(ws + (samp ? S_KVL : P_KVL));
    bfu* U = (bfu*)(ws + (samp ? S_U : P_U)); bfu* PR = (bfu*)(ws + (samp ? S_PR : P_PR));
    float* osh = p.out + (samp ? O_SHS : O_SHP) + (size_t)layer * (samp ? 16 : 8) * 1280;
    epi_loop(acc, wr, wc, fq, [&](int rl, int cbl, const f32x4& v0, const f32x4& v1) {
      const int r = brow + rl + fl;
      _Pragma("unroll") for (int n = 0; n < 2; ++n) {
        const f32x4 v = quad_tr(n ? v1 : v0, o1, o2);
        const int c = bcol + cbl + n * 16 + fc;
        const uint2 pk = make_uint2(pack2(v[0], v[1]), pack2(v[2], v[3]));
        if (c < 256) *(uint2*)(QL + (long)r * 256 + c) = pk;
        else if (c < 416) *(uint2*)(KVL + (long)r * 160 + (c - 256)) = pk;
        else if (c < 672) *(uint2*)(U + (long)r * 256 + (c - 416)) = pk;
        else if (c < 1952) {
          *(uint2*)(PR + (long)r * 1280 + (c - 672)) = pk;
          if ((r & (T - 1)) == T - 1) *(float4*)(osh + (size_t)(r >> LT) * 1280 + (c - 672)) = make_float4(v[0], v[1], v[2], v[3]);
        }
      }
    });
  } else if (kind == K_KV) {
    bfu* KB = (bfu*)(ws + P_KB); bfu* VT = (bfu*)(ws + P_VT);
    epi_loop(acc, wr, wc, fq, [&](int rl, int cbl, const f32x4& v0, const f32x4& v1) {
      const int r0 = brow + rl; const int b = r0 >> 13, t0 = r0 & (SP - 1);
      const int cg16 = bcol + cbl; const int h = cg16 >> 7;
      if ((cg16 & 64) == 0) {
        const float s = rs[rl + fl];
        _Pragma("unroll") for (int n = 0; n < 2; ++n) {
          const f32x4 v = quad_tr(n ? v1 : v0, o1, o2);
          const int w = (cg16 & 127) + n * 16 + fc;
          *(uint2*)(KB + ((long)(b * 6 + h) * SP + t0 + fl) * 96 + w) = make_uint2(pack2(v[0] * s, v[1] * s), pack2(v[2] * s, v[3] * s));
        }
      } else {
        const float s0 = rs[rl], s1 = rs[rl + 1], s2 = rs[rl + 2], s3 = rs[rl + 3];
        _Pragma("unroll") for (int n = 0; n < 2; ++n) {
          const f32x4 v = n ? v1 : v0;
          const int w = (cg16 & 63) + n * 16 + fr;
          *(uint2*)(VT + ((long)(b * 6 + h) * 64 + w) * SP + t0) = make_uint2(pack2(v[0] * s0, v[1] * s1), pack2(v[2] * s2, v[3] * s3));
        }
      }
    });
  } else if (kind == K_GLU) {
    const bfu* U = (const bfu*)(ws + (samp ? S_ZS5 : P_ZS5)); bfu* MG = (bfu*)(ws + (samp ? S_MERGED : P_MERGED));
    const float* bgl = p.in[I_BGLU] + layer * 256;
    epi_loop(acc, wr, wc, fq, [&](int rl, int cbl, const f32x4& v0, const f32x4& v1) {
      const long r = brow + rl + fl;
      _Pragma("unroll") for (int n = 0; n < 2; ++n) {
        const f32x4 v = quad_tr(n ? v1 : v0, o1, o2);
        const int c = bcol + cbl + n * 16 + fc;
        const float4 bg = *(const float4*)(bgl + c);
        const uint2 zu = *(const uint2*)(U + r * 256 + c);
        const float z0 = bf2f(zu.x & 0xffff), z1 = bf2f(zu.x >> 16), z2 = bf2f(zu.y & 0xffff), z3 = bf2f(zu.y >> 16);
        *(uint2*)(MG + r * 1024 + 384 + c) = make_uint2(pack2(z0 * sigmoidf_(v[0] + bg.x), z1 * sigmoidf_(v[1] + bg.y)),
                                                        pack2(z2 * sigmoidf_(v[2] + bg.z), z3 * sigmoidf_(v[3] + bg.w)));
      }
    });
  } else if (kind == K_RES1 || kind == K_RES2) {
    float* Z = (float*)(ws + (samp ? S_Z : (kind == K_RES1 ? P_Z1 : P_Z2)));
    const bfu* X = (const bfu*)(ws + (samp ? OFF_XS : OFF_X));
    epi_loop(acc, wr, wc, fq, [&](int rl, int cbl, const f32x4& v0, const f32x4& v1) {
      const long r = brow + rl + fl;
      _Pragma("unroll") for (int n = 0; n < 2; ++n) {
        const f32x4 v = quad_tr(n ? v1 : v0, o1, o2);
        const int c = bcol + cbl + n * 16 + fc;
        const uint2 xu = *(const uint2*)(X + r * 1024 + c);
        *(float4*)(Z + r * 1024 + c) = make_float4(ALPHA * bf2f(xu.x & 0xffff) + v[0], ALPHA * bf2f(xu.x >> 16) + v[1],
                                                   ALPHA * bf2f(xu.y & 0xffff) + v[2], ALPHA * bf2f(xu.y >> 16) + v[3]);
      }
    });
  } else if (kind == K_UP) {
    bfu* H = (bfu*)(ws + (samp ? S_HID : P_HID));
    epi_loop(acc, wr, wc, fq, [&](int rl, int cbl, const f32x4& v0, const f32x4& v1) {
      const long r = brow + rl + fl;
      _Pragma("unroll") for (int n = 0; n < 2; ++n) {
        const f32x4 v = quad_tr(n ? v1 : v0, o1, o2);
        const int c = bcol + cbl + n * 16 + fc;
        const float x0 = fmaxf(v[0], 0.f), x1 = fmaxf(v[1], 0.f), x2 = fmaxf(v[2], 0.f), x3 = fmaxf(v[3], 0.f);
        *(uint2*)(H + r * 4096 + c) = make_uint2(pack2(x0 * x0, x1 * x1), pack2(x2 * x2, x3 * x3));
      }
    });
  } else {
    bfu* Q = (bfu*)(ws + (samp ? S_Q : P_Q));
    const float2* tab = (const float2*)(ws + OFF_TAB);
    epi_loop(acc, wr, wc, fq, [&](int rl, int cbl, const f32x4& v0, const f32x4& v1) {
      const int cb = bcol + cbl;
      if (cb < 576) {
        const int r = brow + rl + fl; const float s = rs[rl + fl];
        const bool rope = (cb % 96) == 64;
        f32x4 a = quad_tr(v0, o1, o2), b = quad_tr(v1, o1, o2);
        _Pragma("unroll") for (int k = 0; k < 4; ++k) { a[k] *= s; b[k] *= s; }
        if (rope) { const int pos = (r & (T - 1)) + (samp ? 4096 : 0);
          _Pragma("unroll") for (int k = 0; k < 4; ++k) { const float2 cs = tab[pos * 16 + fc + k];
            const float a2 = a[k] * cs.x - b[k] * cs.y, b2 = b[k] * cs.x + a[k] * cs.y; a[k] = a2; b[k] = b2; } }
        *(uint2*)(Q + (long)r * 576 + cb + fc) = make_uint2(pack2(a[0], a[1]), pack2(a[2], a[3]));
        *(uint2*)(Q + (long)r * 576 + cb + 16 + fc) = make_uint2(pack2(b[0], b[1]), pack2(b[2], b[3]));
      }
    });
  }
}

DI Job get_job(const Params& pin, int kind, int layer, int samp) {
  const Params p = relaunder(pin);
  char* ws = p.ws; char* wb = ws + layer * LW_STRIDE;
  Job j; j.kind = kind; j.samp = samp; j.M = samp ? MS : MP;
  switch (kind) {
    case K_PROJ: j.A = (const bfu*)(ws + (samp ? OFF_XS : OFF_X)); j.lda = 1024; j.Bt = (const bfu*)(wb + LW_WIN); j.ldb = 1024; j.N = 2048; j.K = 1024; break;
    case K_Q: j.A = (const bfu*)(ws + (samp ? S_QL : P_QL)); j.lda = 256; j.Bt = (const bfu*)(wb + LW_WQB); j.ldb = 256; j.N = 768; j.K = 256; break;
    case K_KV: j.A = (const bfu*)(ws + P_KVL); j.lda = 160; j.Bt = (const bfu*)(wb + LW_WKV); j.ldb = 128; j.N = 768; j.K = 128; break;
    case K_GLU: j.A = (const bfu*)(ws + (samp ? S_ZS5 : P_ZS5)); j.lda = 256; j.Bt = (const bfu*)(wb + LW_WGLU); j.ldb = 256; j.N = 256; j.K = 256; break;
    case K_RES1: j.A = (const bfu*)(ws + (samp ? S_MERGED : P_MERGED)); j.lda = 1024; j.Bt = (const bfu*)(wb + LW_WOUT); j.ldb = 1024; j.N = 1024; j.K = 1024; break;
    case K_UP: j.A = (const bfu*)(ws + (samp ? OFF_XS : OFF_X)); j.lda = 1024; j.Bt = (const bfu*)(wb + LW_WUP); j.ldb = 1024; j.N = 4096; j.K = 1024; break;
    default: j.A = (const bfu*)(ws + (samp ? S_HID : P_HID)); j.lda = 4096; j.Bt = (const bfu*)(wb + LW_WDN); j.ldb = 4096; j.N = 1024; j.K = 4096; break;
  }
  return j;
}

DI void gemm_do_tile(const Params& pin, const Job& jb, int layer, int wgid, char* shm) {
  const Params p = relaunder(pin);
  const int nM = jb.M / BM, nN = jb.N / BM, nwg = nM * nN;
  { int q = nwg / NXCD, r = nwg % NXCD, xcd = wgid % NXCD, off = wgid / NXCD;
    wgid = (xcd < r ? xcd * (q + 1) : r * (q + 1) + (xcd - r) * q) + off; }
  const int nig = WGM * nN, gid = wgid / nig, fm = gid * WGM, gsz = min(nM - fm, WGM);
  const int pm = fm + ((wgid % nig) % gsz), pn = (wgid % nig) / gsz, brow = pm * BM, bcol = pn * BM;
  f32x4 acc[2][2][4][2];
  gemm_tile(jb.A, jb.Bt, jb.lda, jb.ldb, jb.K, brow, bcol, (bfu*)shm, acc, ltid(p));
  float* rs = (float*)(shm + SHM_MAIN);
  if (jb.kind == K_Q || jb.kind == K_KV) {
    const int tid = ltid(p), row = tid >> 1, half = tid & 1, kh = jb.K / 2;
    const bfu* ap = jb.A + (long)(brow + row) * jb.lda + half * kh;
    float ss = 0.f;
    for (int i = 0; i < kh; i += 8) { uint4 u = *(const uint4*)(ap + i);
      unsigned w[4] = {u.x, u.y, u.z, u.w};
      _Pragma("unroll") for (int k = 0; k < 4; ++k) { float a = bf2f(w[k] & 0xffff), b = bf2f(w[k] >> 16); ss += a * a + b * b; } }
    ss += __shfl_xor(ss, 1);
    float inv = rsqrtf(ss / (float)jb.K + 1e-6f);
    if (jb.kind == K_Q) inv *= QSCALE;
    if (half == 0) rs[row] = inv;
  }
  __syncthreads();
  gemm_epilogue(p, jb, layer, brow, bcol, acc, rs);
  __syncthreads();
}

DI void ln_rows(const Params& pin, int layer, int which  , int final_) {
  const Params p = relaunder(pin);
  const int tidw = ltid(p); const int wave = tidw >> 6, lane = tidw & 63;
  const float* g = p.in[which ? I_LN2G : I_LN1G] + layer * 1024;
  const float* bta = p.in[which ? I_LN2B : I_LN1B] + layer * 1024;
  for (int row = blockIdx.x * 8 + wave; row < MP + MS; row += gridDim.x * 8) {
    const int samp = row >= MP; const long r = samp ? row - MP : row;
    const float* Z = (const float*)(p.ws + (samp ? S_Z : (which ? P_Z2 : P_Z1))) + r * 1024;
    float4 v[4]; float s = 0.f;
    _Pragma("unroll") for (int k = 0; k < 4; ++k) { v[k] = *(const float4*)(Z + k * 256 + lane * 4); s += v[k].x + v[k].y + v[k].z + v[k].w; }
    const float mu = wave_sum(s) * (1.f / 1024);
    float q = 0.f;
    _Pragma("unroll") for (int k = 0; k < 4; ++k) { float a = v[k].x - mu, b = v[k].y - mu, c = v[k].z - mu, d = v[k].w - mu; q += a * a + b * b + c * c + d * d; }
    const float rstd = rsqrtf(wave_sum(q) * (1.f / 1024) + 1e-5f);
    bfu* X = (bfu*)(p.ws + (samp ? OFF_XS : OFF_X)) + r * 1024;
    float* O = p.out + (samp ? O_YS : O_YP) + r * 1024;
    _Pragma("unroll") for (int k = 0; k < 4; ++k) {
      const int c = k * 256 + lane * 4;
      float4 gg = *(const float4*)(g + c), bb = *(const float4*)(bta + c);
      float o0 = (v[k].x - mu) * rstd * gg.x + bb.x, o1 = (v[k].y - mu) * rstd * gg.y + bb.y;
      float o2 = (v[k].z - mu) * rstd * gg.z + bb.z, o3 = (v[k].w - mu) * rstd * gg.w + bb.w;
      if (final_) *(float4*)(O + c) = make_float4(o0, o1, o2, o3);
      else *(uint2*)(X + c) = make_uint2(pack2(o0, o1), pack2(o2, o3));
    }
  }
}

DI void mla_prep_unit(const Params& pin, int layer, int samp, int unit) {
  const Params p = relaunder(pin);
  const int tidw = ltid(p); const int wave = tidw >> 6, lane = tidw & 63;
  const int T = samp ? TS : SP;
  const bfu* KVL = (const bfu*)(p.ws + (samp ? S_KVL : P_KVL));
  const float2* tab = (const float2*)(p.ws + OFF_TAB);
  const float g0 = p.in[I_KVG][layer * 128 + 2 * lane], g1 = p.in[I_KVG][layer * 128 + 2 * lane + 1];
  for (int i = 0; i < 8; ++i) {
    const int r = unit * 64 + i * 8 + wave; const int b = r / T, t = r % T;
    unsigned pr = *(const unsigned*)(KVL + (long)r * 160 + lane * 2);
    float x0 = bf2f(pr & 0xffff), x1 = bf2f(pr >> 16);
    float ss = wave_sum(x0 * x0 + x1 * x1);
    float inv = rsqrtf(ss * (1.f / 128) + 1e-6f);
    float c0 = x0 * inv * g0, c1 = x1 * inv * g1;
    if (!samp) {
      *(float2*)(p.out + O_CKVP + ((size_t)(layer * 8 + b) * SP + t) * 128 + 2 * lane) = make_float2(c0, c1);
    } else {
      *(float2*)(p.out + O_CKVS + ((size_t)(layer * 16 + b) * TS + t) * 128 + 2 * lane) = make_float2(c0, c1);
      bfu* KC = (bfu*)(p.ws + S_KCAT); bfu* VT = (bfu*)(p.ws + S_VT);
      *(unsigned*)(KC + ((long)b * SKP + 4096 + t) * 160 + 2 * lane) = pack2(c0, c1);
      VT[((long)b * 128 + 2 * lane) * SKP + 4096 + t] = f2bf(c0);
      VT[((long)b * 128 + 2 * lane + 1) * SKP + 4096 + t] = f2bf(c1);
    }
    if (lane < 16) {
      float xa = bf2f(KVL[(long)r * 160 + 128 + lane]), xb = bf2f(KVL[(long)r * 160 + 144 + lane]);
      const int pos = t + (samp ? 4096 : 0);
      float2 cs = tab[pos * 16 + lane];
      float o1 = xa * cs.x - xb * cs.y, o2 = xb * cs.x + xa * cs.y;
      if (!samp) {
        float* o = p.out + O_KRP + ((size_t)(layer * 8 + b) * SP + t) * 32; o[lane] = o1; o[lane + 16] = o2;
        bfu* KB = (bfu*)(p.ws + P_KB);
        for (int h = 0; h < 6; ++h) { bfu* kr = KB + ((long)(b * 6 + h) * SP + t) * 96 + 64; kr[lane] = f2bf(o1); kr[lane + 16] = f2bf(o2); }
      } else {
        float* o = p.out + O_KRS + ((size_t)(layer * 16 + b) * TS + t) * 32; o[lane] = o1; o[lane + 16] = o2;
        bfu* kr = (bfu*)(p.ws + S_KCAT) + ((long)b * SKP + 4096 + t) * 160 + 128; kr[lane] = f2bf(o1); kr[lane + 16] = f2bf(o2);
      }
    }
  }
}

DI void cache_conv_unit(const Params& pin, int layer, int unit, char* shm) {
  const Params p = relaunder(pin);
  const int tid = ltid(p), b = unit >> 6, t0 = (unit & 63) * 64;
  const float* ck = p.in[I_CCKV] + ((size_t)(layer * 16 + b) * 4096 + t0) * 128;
  const float* kr = p.in[I_CKR] + ((size_t)(layer * 16 + b) * 4096 + t0) * 32;
  bfu* KC = (bfu*)(p.ws + S_KCAT) + ((long)b * SKP + t0) * 160; bfu* VT = (bfu*)(p.ws + S_VT) + (long)b * 128 * SKP + t0;
  bfu* tl = (bfu*)shm;
  _Pragma("unroll") for (int i = 0; i < 4; ++i) { int e = tid + i * NT, tok = e >> 5, c4 = (e & 31) * 4;
    float4 v = *(const float4*)(ck + tok * 128 + c4);
    *(uint2*)(KC + (long)tok * 160 + c4) = make_uint2(pack2(v.x, v.y), pack2(v.z, v.w));
    tl[(c4 + 0) * 72 + tok] = f2bf(v.x); tl[(c4 + 1) * 72 + tok] = f2bf(v.y); tl[(c4 + 2) * 72 + tok] = f2bf(v.z); tl[(c4 + 3) * 72 + tok] = f2bf(v.w); }
  _Pragma("unroll") for (int i = 0; i < 4; ++i) { int e = tid + i * NT, tok = e >> 5, c = e & 31; KC[(long)tok * 160 + 128 + c] = f2bf(kr[tok * 32 + c]); }
  __syncthreads();
  _Pragma("unroll") for (int i = 0; i < 2; ++i) { int e = tid + i * NT, c = e >> 3, part = e & 7;
    *(uint4*)(VT + (long)c * SKP + part * 8) = *(const uint4*)(tl + c * 72 + part * 8); }
  __syncthreads();
}

DI void rwkv_prep_unit(const Params& pin, int layer, int samp, int unit, char* shm) {
  const Params p = relaunder(pin);
  const int tid = ltid(p), wave = tid >> 6, lane = tid & 63;
  const int T = samp ? TS : SP; const int r0 = unit * 32, b = r0 / T, t0 = r0 % T;
  const bfu* PR = (const bfu*)(p.ws + (samp ? S_PR : P_PR));
  const float* mu = p.in[I_MU] + layer * 1280;
  const float* sh0 = samp ? p.in[I_SSH] + (size_t)(layer * 16 + b) * 1280 : nullptr;
  float* lor = (float*)shm;
  for (int e = tid; e < 4096; e += NT) {
    const int tk = e >> 7, c = e & 127, col = 1152 + c;
    float cur = bf2f(PR[(long)(r0 + tk) * 1280 + col]);
    float prev = (t0 + tk == 0) ? (sh0 ? sh0[col] : 0.f) : bf2f(PR[(long)(r0 + tk - 1) * 1280 + col]);
    float ps = cur + (prev - cur) * mu[col];
    lor[e] = (c < 32) ? tanhf_(ps) : (c < 64 ? ps : sigmoidf_(ps));
  }
  __syncthreads();
  if (wave < 6) {
    const int h = wave, c = h * 64 + lane;
    bfu* RW = (bfu*)(p.ws + (samp ? S_RW : P_RW)); bfu* G = (bfu*)(p.ws + (samp ? S_G : P_G)); float* BON = (float*)(p.ws + (samp ? S_BON : P_BON));
    {
      float ww[32], wa[32];
      const float* W2 = p.in[I_WW2] + (size_t)layer * 32 * 384, *A2 = p.in[I_WA2] + (size_t)layer * 32 * 384;
      _Pragma("unroll") for (int k = 0; k < 32; ++k) { ww[k] = W2[k * 384 + c]; wa[k] = A2[k * 384 + c]; }
      const float w0 = p.in[I_W0][layer * 384 + c], a0 = p.in[I_A0][layer * 384 + c], kkc = p.in[I_KK][layer * 384 + c],
                  kac = p.in[I_KA][layer * 384 + c], rkc = p.in[I_RK][layer * 384 + c];
      const float mur = mu[c], muk = mu[384 + c], muv = mu[768 + c];
      float pr_, pk_, pv_;
      if (t0 == 0) { pr_ = sh0 ? sh0[c] : 0.f; pk_ = sh0 ? sh0[384 + c] : 0.f; pv_ = sh0 ? sh0[768 + c] : 0.f; }
      else { const bfu* q = PR + (long)(r0 - 1) * 1280; pr_ = bf2f(q[c]); pk_ = bf2f(q[384 + c]); pv_ = bf2f(q[768 + c]); }
      for (int tk = 0; tk < 32; ++tk) {
        const float* lr = lor + tk * 128;
        float accw = w0, acca = a0;
        _Pragma("unroll") for (int k = 0; k < 32; k += 4) { float4 x = *(const float4*)(lr + k);
          accw += x.x * ww[k] + x.y * ww[k + 1] + x.z * ww[k + 2] + x.w * ww[k + 3]; }
        _Pragma("unroll") for (int k = 0; k < 32; k += 4) { float4 x = *(const float4*)(lr + 32 + k);
          acca += x.x * wa[k] + x.y * wa[k + 1] + x.z * wa[k + 2] + x.w * wa[k + 3]; }
        const bfu* q = PR + (long)(r0 + tk) * 1280;
        const float cr = bf2f(q[c]), ck = bf2f(q[384 + c]), cv = bf2f(q[768 + c]);
        const float r = cr + (pr_ - cr) * mur, k = ck + (pk_ - ck) * muk, v = cv + (pv_ - cv) * muv;
        pr_ = cr; pk_ = ck; pv_ = cv;
        const float z = -accw;
        const float sp = fmaxf(z, 0.f) + __logf(1.f + __expf(-fabsf(z)));
        const float wlog = -sp - 0.5f;
        const float e = __expf(wlog);
        const float d = 1.f - __expf(-e);
        const float a = sigmoidf_(acca);
        const float kkr = k * kkc;
        const float n2 = wave_sum(kkr * kkr);
        const float kk = kkr / fmaxf(sqrtf(n2), 1e-12f);
        const float k2 = k * (1.f + (a - 1.f) * kac);
        const float bon = wave_sum(r * k2 * rkc);
        const long tok = (long)(b * 6 + h) * T + t0 + tk;
        bfu* o = RW + tok * 384;
        o[lane] = f2bf(d); o[64 + lane] = f2bf(k2); o[128 + lane] = f2bf(kk); o[192 + lane] = f2bf(-kk * a); o[256 + lane] = f2bf(r); o[320 + lane] = f2bf(v);
        if (lane == 0) BON[(long)(r0 + tk) * 6 + h] = bon;
      }
    }
    {
      float wg[64];
      const float* G2 = p.in[I_WG2] + (size_t)layer * 64 * 384;
      _Pragma("unroll") for (int k = 0; k < 64; ++k) wg[k] = G2[k * 384 + c];
      for (int tk = 0; tk < 32; ++tk) {
        const float* lr = lor + tk * 128;
        float accg = 0.f;
        _Pragma("unroll") for (int k = 0; k < 64; k += 4) { float4 x = *(const float4*)(lr + 64 + k);
          accg += x.x * wg[k] + x.y * wg[k + 1] + x.z * wg[k + 2] + x.w * wg[k + 3]; }
        G[(long)(r0 + tk) * 384 + c] = f2bf(accg);
      }
    }
  }
  __syncthreads();
}

DI void rwkv_scan_unit(const Params& pin, int layer, int samp, int unit, char* shm) {
  const Params p = relaunder(pin);
  const int tid = ltid(p), wave = tid >> 6, lane = tid & 63, rg = lane >> 4, cgi = lane & 15;
  const int T = samp ? TS : SP; const int half = unit & 1, bh = unit >> 1; const int b = bh / 6, h = bh % 6;
  const bool act = wave < 4;
  const int row0 = half * 32 + (wave & 3) * 8 + rg * 2, col0 = cgi * 4;
  const bfu* RW = (const bfu*)(p.ws + (samp ? S_RW : P_RW)) + (long)bh * T * 384;
  bfu* Y = (bfu*)(p.ws + (samp ? S_Y : P_Y)) + (long)b * T * 384 + h * 64;
  float S[2][4];
  if (samp) { const float* s0 = p.in[I_SRW] + ((size_t)(layer * 16 + b) * 6 + h) * 4096;
    _Pragma("unroll") for (int rr = 0; rr < 2; ++rr) { float4 v = *(const float4*)(s0 + (row0 + rr) * 64 + col0); S[rr][0] = v.x; S[rr][1] = v.y; S[rr][2] = v.z; S[rr][3] = v.w; } }
  else { _Pragma("unroll") for (int rr = 0; rr < 2; ++rr) _Pragma("unroll") for (int c = 0; c < 4; ++c) S[rr][c] = 0.f; }
  const int nch = T / 32;
  uint4 st[3];
  _Pragma("unroll") for (int i = 0; i < 3; ++i) st[i] = *(const uint4*)(RW + (long)(tid + i * NT) * 8);
  for (int ch = 0; ch < nch; ++ch) {
    float* L = (float*)(shm + (ch & 1) * 49152);
    _Pragma("unroll") for (int i = 0; i < 3; ++i) { const unsigned w[4] = {st[i].x, st[i].y, st[i].z, st[i].w}; float* d = L + (tid + i * NT) * 8;
      *(float4*)d = make_float4(bf2f(w[0] & 0xffff), bf2f(w[0] >> 16), bf2f(w[1] & 0xffff), bf2f(w[1] >> 16));
      *(float4*)(d + 4) = make_float4(bf2f(w[2] & 0xffff), bf2f(w[2] >> 16), bf2f(w[3] & 0xffff), bf2f(w[3] >> 16)); }
    __syncthreads();
    if (ch + 1 < nch) _Pragma("unroll") for (int i = 0; i < 3; ++i) st[i] = *(const uint4*)(RW + (long)(ch + 1) * 32 * 384 + (long)(tid + i * NT) * 8);
    if (act) for (int s = 0; s < 32; ++s) {
      const float* q = L + s * 384;
      const float4 d4 = *(const float4*)(q + col0), k4 = *(const float4*)(q + 64 + col0), kk4 = *(const float4*)(q + 128 + col0),
                   ka4 = *(const float4*)(q + 192 + col0), r4 = *(const float4*)(q + 256 + col0);
      const float2 v2 = *(const float2*)(q + 320 + row0);
      const float w0 = 1.f - d4.x, w1 = 1.f - d4.y, w2 = 1.f - d4.z, w3 = 1.f - d4.w;
      float yv[2];
      _Pragma("unroll") for (int rr = 0; rr < 2; ++rr) {
        const float vv = rr ? v2.y : v2.x;
        float sa = S[rr][0] * kk4.x + S[rr][1] * kk4.y + S[rr][2] * kk4.z + S[rr][3] * kk4.w;
        const float b0 = S[rr][0] * w0 + vv * k4.x, b1 = S[rr][1] * w1 + vv * k4.y, b2 = S[rr][2] * w2 + vv * k4.z, b3 = S[rr][3] * w3 + vv * k4.w;
        sa = allred16(sa);
        S[rr][0] = b0 + sa * ka4.x; S[rr][1] = b1 + sa * ka4.y; S[rr][2] = b2 + sa * ka4.z; S[rr][3] = b3 + sa * ka4.w;
        float y = S[rr][0] * r4.x + S[rr][1] * r4.y + S[rr][2] * r4.z + S[rr][3] * r4.w;
        yv[rr] = allred16(y);
      }
      if (cgi == 0) *(unsigned*)(Y + (long)(ch * 32 + s) * 384 + row0) = pack2(yv[0], yv[1]);
    }
  }
  float* so = p.out + (samp ? O_RWS : O_RWP) + ((size_t)(layer * (samp ? 16 : 8) + b) * 6 + h) * 4096;
  if (act) _Pragma("unroll") for (int rr = 0; rr < 2; ++rr) *(float4*)(so + (row0 + rr) * 64 + col0) = make_float4(S[rr][0], S[rr][1], S[rr][2], S[rr][3]);
  __syncthreads();
}

DI void s5_unit(const Params& pin, int layer, int samp, int unit, char* shm) {
  const Params p = relaunder(pin);
  const int tid = ltid(p), wave = tid >> 6, lane = tid & 63;
  const int T = samp ? TS : SP; const int b = unit >> 1, g = (unit & 1) * 8 + wave;
  const int gp = (layer * 16 + g) * 64 + lane;
  const float lre = p.in[I_LRE][gp], lim = p.in[I_LIM][gp];
  const float dt = expf(p.in[I_LDT][layer * 16 + g]);
  const float ang = lim * dt;
  const float sn = sinf(ang), cs = cosf(ang);
  const float mag = expf(lre * dt);
  const float lr = mag * cs, li = mag * sn;
  const float nr = lr - 1.f, ni = li, den = lre * lre + lim * lim;
  const float cr_ = (nr * lre + ni * lim) / den, ci_ = (ni * lre - nr * lim) / den;
  float Br[16], Bi[16];
  { const float* bre = p.in[I_BRE] + (size_t)gp * 16, *bim = p.in[I_BIM] + (size_t)gp * 16;
    _Pragma("unroll") for (int c = 0; c < 16; ++c) { const float br = bre[c], bi = bim[c]; Br[c] = cr_ * br - ci_ * bi; Bi[c] = cr_ * bi + ci_ * br; } }
  bf16x8 Cf[4];
  { const int n = lane & 15, kg = lane >> 4;
    const float* cre = p.in[I_CRE] + ((size_t)(layer * 16 + g) * 16 + n) * 64, *cim = p.in[I_CIM] + ((size_t)(layer * 16 + g) * 16 + n) * 64;
    _Pragma("unroll") for (int s = 0; s < 4; ++s) _Pragma("unroll") for (int j = 0; j < 8; ++j) { int k = 32 * s + 8 * kg + j;
      float v = (k < 64) ? cre[k] : -cim[k - 64]; Cf[s][j] = (short)f2bf(v); } }
  const float Dd = p.in[I_S5D][layer * 256 + g * 16 + (lane & 15)];
  float xr = 0.f, xi = 0.f;
  if (samp) { const float* s0 = p.in[I_SS5] + ((size_t)(layer * 16 + b) * 16 + g) * 128 + lane * 2; xr = s0[0]; xi = s0[1]; }
  char* wsm = shm + wave * 6144;
  float* ut = (float*)wsm; bfu* xt = (bfu*)(wsm + 1024);
  const bfu* U = (const bfu*)(p.ws + (samp ? S_U : P_U)) + (long)b * T * 256 + g * 16;
  bfu* ZO = (bfu*)(p.ws + (samp ? S_ZS5 : P_ZS5)) + (long)b * T * 256 + g * 16;
  uint4 un = make_uint4(0, 0, 0, 0);
  if (lane < 32) un = *(const uint4*)(U + (long)(lane >> 1) * 256 + (lane & 1) * 8);
  for (int t0 = 0; t0 < T; t0 += 16) {
    if (lane < 32) { const unsigned w[4] = {un.x, un.y, un.z, un.w}; float* d = ut + (lane >> 1) * 16 + (lane & 1) * 8;
      *(float4*)d = make_float4(bf2f(w[0] & 0xffff), bf2f(w[0] >> 16), bf2f(w[1] & 0xffff), bf2f(w[1] >> 16));
      *(float4*)(d + 4) = make_float4(bf2f(w[2] & 0xffff), bf2f(w[2] >> 16), bf2f(w[3] & 0xffff), bf2f(w[3] >> 16)); }
    if (t0 + 16 < T && lane < 32) un = *(const uint4*)(U + (long)(t0 + 16 + (lane >> 1)) * 256 + (lane & 1) * 8);
    __builtin_amdgcn_fence(__ATOMIC_RELEASE, "wavefront"); __builtin_amdgcn_wave_barrier(); __builtin_amdgcn_fence(__ATOMIC_ACQUIRE, "wavefront");
    for (int tt = 0; tt < 16; ++tt) {
      const float4* up = (const float4*)(ut + tt * 16);
      const float4 u0 = up[0], u1 = up[1], u2 = up[2], u3 = up[3];
      const float u[16] = {u0.x, u0.y, u0.z, u0.w, u1.x, u1.y, u1.z, u1.w, u2.x, u2.y, u2.z, u2.w, u3.x, u3.y, u3.z, u3.w};
      float br = 0.f, bi = 0.f;
      _Pragma("unroll") for (int c = 0; c < 16; ++c) { br += Br[c] * u[c]; bi += Bi[c] * u[c]; }
      const float nxr = lr * xr - li * xi + br, nxi = lr * xi + li * xr + bi;
      xr = nxr; xi = nxi;
      xt[tt * 136 + lane] = f2bf(xr); xt[tt * 136 + 64 + lane] = f2bf(xi);
    }
    __builtin_amdgcn_fence(__ATOMIC_RELEASE, "wavefront"); __builtin_amdgcn_wave_barrier(); __builtin_amdgcn_fence(__ATOMIC_ACQUIRE, "wavefront");
    f32x4 acc = {0.f, 0.f, 0.f, 0.f};
    { const int row = lane & 15, kg = lane >> 4;
      _Pragma("unroll") for (int s = 0; s < 4; ++s) { bf16x8 a = *(const bf16x8*)(xt + row * 136 + 32 * s + 8 * kg);
        acc = __builtin_amdgcn_mfma_f32_16x16x32_bf16(a, Cf[s], acc, 0, 0, 0); } }
    { const int ch = lane & 15, tq = lane >> 4;
      _Pragma("unroll") for (int r = 0; r < 4; ++r) { const int tk = tq * 4 + r;
        float y = acc[r] + Dd * ut[tk * 16 + ch];
        float z = 0.5f * y * (1.f + tanhf_(0.7978845608028654f * (y + 0.044715f * y * y * y)));
        ZO[(long)(t0 + tk) * 256 + ch] = f2bf(z); } }
    __builtin_amdgcn_fence(__ATOMIC_RELEASE, "wavefront"); __builtin_amdgcn_wave_barrier(); __builtin_amdgcn_fence(__ATOMIC_ACQUIRE, "wavefront");
  }
  float* so = p.out + (samp ? O_S5S : O_S5P) + ((size_t)(layer * (samp ? 16 : 8) + b) * 16 + g) * 128 + lane * 2;
  so[0] = xr; so[1] = xi;
}

template <int DQK, int DV>
struct Attn {
  static constexpr int PK = DQK * 2 + 16, PV = 144;
  static constexpr int KT_BYTES = 64 * PK, VT_BYTES = DV * PV, BUF = KT_BYTES + VT_BYTES;
  static constexpr int NCK = 64 * DQK / 8, NCV = DV * 8, NC = NCK + NCV, NLD = (NC + NT - 1) / NT;
  static_assert(NLD <= 5, "NLD");
  static constexpr int NS = DQK / 16, NMT = DV / 32;
  static_assert(2 * BUF + 49152 <= SHM_MAIN, "attn LDS");


  struct St { uint4 a0, a1, a2, a3, a4; };
  template <int I> static DI void g1(uint4& s, const bfu* Kbase, const bfu* Vtbase, long Tstride, int tile, const int tid) {
    if constexpr (I < NLD) { const int c = tid + I * NT;
      if (c < NCK) s = *(const uint4*)(Kbase + (long)tile * 64 * DQK + (long)c * 8);
      else if (c < NC) { const int cv = c - NCK, d = cv >> 3, part = cv & 7; s = *(const uint4*)(Vtbase + (long)d * Tstride + (long)tile * 64 + part * 8); } }
  }
  template <int I> static DI void s1(const uint4& s, char* base, const int tid) {
    if constexpr (I < NLD) { const int c = tid + I * NT;
      if (c < NCK) { const int row = c / (DQK / 8), col = c % (DQK / 8); *(uint4*)(base + row * PK + col * 16) = s; }
      else if (c < NC) { const int cv = c - NCK, d = cv >> 3, part = cv & 7; *(uint4*)(base + KT_BYTES + d * PV + part * 16) = s; } }
  }
  static DI void gload(St& st, const bfu* Kbase, const bfu* Vtbase, long Tstride, int tile, const int tid) {
    g1<0>(st.a0, Kbase, Vtbase, Tstride, tile, tid); g1<1>(st.a1, Kbase, Vtbase, Tstride, tile, tid); g1<2>(st.a2, Kbase, Vtbase, Tstride, tile, tid);
    g1<3>(st.a3, Kbase, Vtbase, Tstride, tile, tid); g1<4>(st.a4, Kbase, Vtbase, Tstride, tile, tid);
  }
  static DI void lstore(const St& st, char* shm, int buf, const int tid) {
    char* base = shm + buf * BUF;
    s1<0>(st.a0, base, tid); s1<1>(st.a1, base, tid); s1<2>(st.a2, base, tid); s1<3>(st.a3, base, tid); s1<4>(st.a4, base, tid);
  }
  static DI void run(const bfu* Kbase, const bfu* Vtbase, long Tstride, int ntiles_unit, int my_ntiles, int key_limit,
                     const bfu* qptr  , char* shm, f32x16 (&O)[NMT], float& lsum, const int tid) {
    const int lane = tid & 63, ln = lane & 31, hh = lane >> 5;
    bf16x8 qf[NS];
    if (my_ntiles > 0) _Pragma("unroll") for (int s = 0; s < NS; ++s) qf[s] = *(const bf16x8*)(qptr + s * 16 + hh * 8);
    else _Pragma("unroll") for (int s = 0; s < NS; ++s) qf[s] = bf16x8{0, 0, 0, 0, 0, 0, 0, 0};
    _Pragma("unroll") for (int mt = 0; mt < NMT; ++mt) _Pragma("unroll") for (int r = 0; r < 16; ++r) O[mt][r] = 0.f;
    float mrun = -1e30f, l = 0.f;
    St st; st.a0 = st.a1 = st.a2 = st.a3 = st.a4 = make_uint4(0, 0, 0, 0);
    gload(st, Kbase, Vtbase, Tstride, 0, tid); lstore(st, shm, 0, tid); __syncthreads();
    for (int kt = 0; kt < ntiles_unit; ++kt) {
      if (kt + 1 < ntiles_unit) gload(st, Kbase, Vtbase, Tstride, kt + 1, tid);
      if (kt < my_ntiles) {
        const char* kb = shm + (kt & 1) * BUF; const char* vb = kb + KT_BYTES;
        f32x16 s[2];
        _Pragma("unroll") for (int k2 = 0; k2 < 2; ++k2) {
          _Pragma("unroll") for (int r = 0; r < 16; ++r) s[k2][r] = 0.f;
          _Pragma("unroll") for (int si = 0; si < NS; ++si) {
            bf16x8 a = *(const bf16x8*)(kb + (k2 * 32 + ln) * PK + (si * 16 + hh * 8) * 2);
            s[k2] = __builtin_amdgcn_mfma_f32_32x32x16_bf16(a, qf[si], s[k2], 0, 0, 0);
          }
        }
        if ((kt + 1) * 64 > key_limit) {
          _Pragma("unroll") for (int k2 = 0; k2 < 2; ++k2) _Pragma("unroll") for (int r = 0; r < 16; ++r) { int key = kt * 64 + k2 * 32 + crow(r, hh); if (key >= key_limit) s[k2][r] = -1e30f; }
        }
        float mx = -1e30f;
        _Pragma("unroll") for (int k2 = 0; k2 < 2; ++k2) _Pragma("unroll") for (int r = 0; r < 16; ++r) mx = fmaxf(mx, s[k2][r]);
        mx = fmaxf(mx, __shfl_xor(mx, 32));
        const float mnew = fmaxf(mrun, mx);
        const float corr = __builtin_amdgcn_exp2f(mrun - mnew);
        mrun = mnew; l *= corr;
        _Pragma("unroll") for (int mt = 0; mt < NMT; ++mt) _Pragma("unroll") for (int r = 0; r < 16; ++r) O[mt][r] *= corr;
        _Pragma("unroll") for (int k2 = 0; k2 < 2; ++k2) _Pragma("unroll") for (int r = 0; r < 16; ++r) { float pv = __builtin_amdgcn_exp2f(s[k2][r] - mnew); l += pv; s[k2][r] = pv; }
        _Pragma("unroll") for (int k2 = 0; k2 < 2; ++k2) _Pragma("unroll") for (int sp = 0; sp < 2; ++sp) {
          bf16x8 pf;
          _Pragma("unroll") for (int j = 0; j < 8; ++j) pf[j] = (short)f2bf(s[k2][8 * sp + j]);
          _Pragma("unroll") for (int mt = 0; mt < NMT; ++mt) {
            const char* vp = vb + (mt * 32 + ln) * PV + (k2 * 32 + sp * 16 + hh * 4) * 2;
            s16x4 lo = *(const s16x4*)vp, hi = *(const s16x4*)(vp + 16);
            bf16x8 vf = __builtin_shufflevector(lo, hi, 0, 1, 2, 3, 4, 5, 6, 7);
            O[mt] = __builtin_amdgcn_mfma_f32_32x32x16_bf16(vf, pf, O[mt], 0, 0, 0);
          }
        }
      }
      if (kt + 1 < ntiles_unit) lstore(st, shm, (kt + 1) & 1, tid);
      __syncthreads();
    }
    lsum = l + __shfl_xor(l, 32);
  }
};

DI void attn_prompt_unit(const Params& pin, int unit, char* shm) {
  const Params p = relaunder(pin);
  const int qb = 31 - unit / 48, bh = unit % 48, b = bh / 6, h = bh % 6;
  const int tidu = ltid(p);
  const int wave = tidu >> 6, lane = tidu & 63, ln = lane & 31, hh = lane >> 5;
  const int q0 = qb * 256 + wave * 32;
  const bfu* Kb = (const bfu*)(p.ws + P_KB) + (long)bh * SP * 96;
  const bfu* Vt = (const bfu*)(p.ws + P_VT) + (long)bh * 64 * SP;
  const bfu* Q = (const bfu*)(p.ws + P_Q) + ((long)b * SP + q0 + ln) * 576 + h * 96;
  f32x16 O[2]; float lsum;
  Attn<96, 64>::run(Kb, Vt, SP, qb * 4 + 4, q0 / 64 + 1, 1 << 30, Q, shm, O, lsum, tidu);
  const float inv = 1.f / lsum;
  bfu* MG = (bfu*)(p.ws + P_MERGED) + ((long)b * SP + q0 + ln) * 1024 + h * 64;
  _Pragma("unroll") for (int mt = 0; mt < 2; ++mt) _Pragma("unroll") for (int g = 0; g < 4; ++g) {
    const int d0 = mt * 32 + 8 * g + 4 * hh;
    *(uint2*)(MG + d0) = make_uint2(pack2(O[mt][4 * g] * inv, O[mt][4 * g + 1] * inv), pack2(O[mt][4 * g + 2] * inv, O[mt][4 * g + 3] * inv));
  }
}

DI void attn_sample_unit(const Params& pin, int layer, int b, char* shm) {
  const Params p = relaunder(pin);
  const int tid = ltid(p), wave = tid >> 6, lane = tid & 63, ln = lane & 31, hh = lane >> 5;
  const bfu* Qs = (const bfu*)(p.ws + S_Q);
  bfu* QA = (bfu*)(p.ws + S_QABS);
  const float* WK = p.in[I_WKVB] + (size_t)layer * 128 * 768;
  for (int it = tid; it < 768; it += NT) {
    const int h = it >> 7, c = it & 127;
    float wcol[64];
    _Pragma("unroll") for (int d = 0; d < 64; d += 4) { float4 v = *(const float4*)(WK + c * 768 + h * 128 + d); wcol[d] = v.x; wcol[d + 1] = v.y; wcol[d + 2] = v.z; wcol[d + 3] = v.w; }
    for (int row = 0; row < 32; ++row) {
      const bfu* q = Qs + (long)(b * 32 + row) * 576 + h * 96;
      float acc = 0.f;
      _Pragma("unroll") for (int d = 0; d < 64; ++d) acc += bf2f(q[d]) * wcol[d];
      QA[((long)(b * 6 + h) * 32 + row) * 160 + c] = f2bf(acc);
    }
  }
  for (int e = tid; e < 6 * 32 * 32; e += NT) { const int h = e >> 10, row = (e >> 5) & 31, c = e & 31;
    QA[((long)(b * 6 + h) * 32 + row) * 160 + 128 + c] = Qs[(long)(b * 32 + row) * 576 + h * 96 + 64 + c]; }
  __threadfence(); __syncthreads();
  const bfu* Kc = (const bfu*)(p.ws + S_KCAT) + (long)b * SKP * 160;
  const bfu* Vt = (const bfu*)(p.ws + S_VT) + (long)b * 128 * SKP;
  const int hw = wave < 6 ? wave : 0;
  const bfu* Q = QA + ((long)(b * 6 + hw) * 32 + ln) * 160;
  bfu* stash = (bfu*)(shm + 2 * Attn<160, 64>::BUF);
  for (int half = 0; half < 2; ++half) {
    f32x16 O[2]; float lsum;
    Attn<160, 64>::run(Kc, Vt + (long)half * 64 * SKP, SKP, 65, wave < 6 ? 65 : 0, SKS, Q, shm, O, lsum, tid);
    if (wave < 6) { const float inv = 1.f / lsum;
      _Pragma("unroll") for (int mt = 0; mt < 2; ++mt) _Pragma("unroll") for (int r = 0; r < 16; ++r)
        stash[half * 12288 + (wave * 32 + ln) * 64 + mt * 32 + crow(r, hh)] = f2bf(O[mt][r] * inv); }
    __syncthreads();
  }
  if (wave < 6) {
    const int h = wave, c = lane;
    float acc[32];
    _Pragma("unroll") for (int r = 0; r < 32; ++r) acc[r] = 0.f;
    for (int d = 0; d < 128; ++d) { const float w = WK[d * 768 + h * 128 + 64 + c];
      const bfu* o = stash + (d >> 6) * 12288 + h * 32 * 64 + (d & 63);
      _Pragma("unroll") for (int r = 0; r < 32; ++r) acc[r] += bf2f(o[r * 64]) * w; }
    bfu* MG = (bfu*)(p.ws + S_MERGED);
    _Pragma("unroll") for (int r = 0; r < 32; ++r) MG[(long)(b * 32 + r) * 1024 + h * 64 + c] = f2bf(acc[r]);
  }
  __syncthreads();
}

DI void rwkv_post(const Params& pin, int layer) {
  const Params p = relaunder(pin);
  const int tidw = ltid(p); const int wave = tidw >> 6, lane = tidw & 63;
  const long total = (long)(MP + MS) * 6;
  for (long u0 = ((long)blockIdx.x * 8 + wave) * 4; u0 < total; u0 += (long)gridDim.x * 8 * 4) {
    float y[4], v[4], gg[4], bon[4]; long mgo[4]; int cc[4]; int sm[4];
    _Pragma("unroll") for (int i = 0; i < 4; ++i) {
      const long u = u0 + i;
      const int samp = u >= (long)MP * 6; const long uu = samp ? u - (long)MP * 6 : u;
      const long r = uu / 6; const int h = (int)(uu - r * 6); const int LT = samp ? 5 : 13; const int T = 1 << LT;
      const long b = r >> LT, t = r & (T - 1); const int c = h * 64 + lane;
      const bfu* Y = (const bfu*)(p.ws + (samp ? S_Y : P_Y)); const bfu* G = (const bfu*)(p.ws + (samp ? S_G : P_G));
      const float* BON = (const float*)(p.ws + (samp ? S_BON : P_BON)); const bfu* RW = (const bfu*)(p.ws + (samp ? S_RW : P_RW));
      y[i] = bf2f(Y[r * 384 + c]);
      v[i] = bf2f(RW[((b * 6 + h) * T + t) * 384 + 320 + lane]);
      gg[i] = bf2f(G[r * 384 + c]); bon[i] = BON[r * 6 + h];
      mgo[i] = r * 1024 + 640 + c; cc[i] = c; sm[i] = samp;
    }
    _Pragma("unroll") for (int i = 0; i < 4; ++i) {
      const float mu = wave_sum(y[i]) * (1.f / 64);
      const float dv = y[i] - mu;
      const float var = wave_sum(dv * dv) * (1.f / 64);
      float o = dv * rsqrtf(var + 64e-5f) * p.in[I_GNG][layer * 384 + cc[i]] + p.in[I_GNB][layer * 384 + cc[i]];
      o = (o + bon[i] * v[i]) * gg[i];
      bfu* MG = (bfu*)(p.ws + (sm[i] ? S_MERGED : P_MERGED));
      MG[mgo[i]] = f2bf(o);
    }
  }
}

DI void run_phase(const Params& p, int ph, int spos, char* shm) {
  if (ph == 0) { U_INIT(phase_init(p, shm)); return; }
  const int layer = (ph - 1) / 9, sub = (ph - 1) % 9;
  const int bid = blockIdx.x, G = gridDim.x;
  int nj = 0, k0 = 0, k1 = 0, k2 = 0, s0 = 0, s1 = 1, s2 = 0, n0 = 0, n1 = 0, n2 = 0;
  if (sub == 0) { nj = 2; k0 = k1 = K_PROJ; n0 = 2048; n1 = 16; }
  else if (sub == 1) { nj = 3; k0 = k1 = K_Q; k2 = K_KV; n0 = 768; n1 = 6; n2 = 768; }
  else if (sub == 3) { nj = 2; k0 = k1 = K_GLU; n0 = 256; n1 = 2; }
  else if (sub == 4) { nj = 2; k0 = k1 = K_RES1; n0 = 1024; n1 = 8; }
  else if (sub == 6) { nj = 2; k0 = k1 = K_UP; n0 = 4096; n1 = 32; }
  else if (sub == 7) { nj = 2; k0 = k1 = K_RES2; n0 = 1024; n1 = 8; }
  if (nj > 0) {
    const int tot = n0 + n1 + n2;
    for (int t = bid; t < tot; t += G) {
      int kind, samp, lt;
      if (t < n0) { kind = k0; samp = s0; lt = t; } else if (t < n0 + n1) { kind = k1; samp = s1; lt = t - n0; } else { kind = k2; samp = s2; lt = t - n0 - n1; }
      const Job j = get_job(p, kind, layer, samp);
      U_GEMM(gemm_do_tile(p, j, layer, lt, shm));
    }
  }
  if (sub == 1) {
    const int nrp = 2048, nrs = 16, nmp = 1024, nms = 8, ncc = 1024;
    const int e3 = nrp, e4 = e3 + nrs, e5 = e4 + nmp, e6 = e5 + nms, e7 = e6 + ncc;
    for (int t = bid; t < e7; t += G) {
      if (t < e4) U_RP(rwkv_prep_unit(p, layer, t >= e3, t < e3 ? t : t - e3, shm));
      else if (t < e6) mla_prep_unit(p, layer, t >= e5, t < e5 ? t - e4 : t - e5);
      else U_CC(cache_conv_unit(p, layer, t - e6, shm));
    }
  } else if (sub == 2) {
    unsigned* ctr = (unsigned*)(p.ws + OFF_CTL) + spos;
    int* su = (int*)(shm + SHM_MAIN + 1024);
    const int total = 96 + 16 + 16 + 1536 + 192 + 32;
    while (true) {
      if (ltid(p) == 0) *su = (int)atomicAdd(ctr, 1u);
      __syncthreads();
      const int u = *su;
      __syncthreads();
      if (u >= total) break;
      if (u < 96 || (u >= 1664 && u < 1856)) U_SCAN(rwkv_scan_unit(p, layer, u >= 96, u < 96 ? u : u - 1664, shm));
      else if (u < 112 || u >= 1856) U_S5(s5_unit(p, layer, u >= 112, u < 112 ? u - 96 : u - 1856, shm));
      else if (u < 128) U_AS(attn_sample_unit(p, layer, u - 112, shm));
      else U_AP(attn_prompt_unit(p, u - 128, shm));
      __syncthreads();
    }
  } else if (sub == 3) {
    rwkv_post(p, layer);
  } else if (sub == 5) {
    ln_rows(p, layer, 0, 0);
  } else if (sub == 8) {
    ln_rows(p, layer, 1, layer == 1);
  }
}

#ifndef SCHED_LIST
#define SCHED_LIST 0, 1, 2, 3, 4, 5, 6, 7, 8, 9, 10, 11, 12, 13, 14, 15, 16, 17, 18
#endif
__constant__ int c_sched[] = {SCHED_LIST};
constexpr int NSCHED = sizeof((int[]){SCHED_LIST}) / sizeof(int);

__global__ void __launch_bounds__(NT) mega(Params p, int ph_lo, int ph_hi) {
  __shared__ __attribute__((aligned(16))) char shm[SHM_BYTES];
  p.wave = __builtin_amdgcn_readfirstlane((int)(threadIdx.x >> 6));
#if MULTI
  for (int i = ph_lo; i < ph_hi; ++i) run_phase(p, c_sched[i], i, shm);
#else
  cg::grid_group grid = cg::this_grid();
  for (int i = ph_lo; i < ph_hi; ++i) { run_phase(p, c_sched[i], i, shm); if (i + 1 < ph_hi) grid.sync(); }
#endif
}

extern "C" void kernel_launch(void* const* d_in, const int* in_sizes, int n_in, void* d_out, int out_size, void* d_ws, size_t ws_size,
                              hipStream_t stream) {
  Params p{};
  _Pragma("unroll") for (int i = 0; i < 40; ++i) p.in[i] = (const float*)d_in[i];
  p.out = (float*)d_out; p.ws = (char*)d_ws;
  if (ws_size < WS_NEED) { fprintf(stderr, "workspace too small: %zu < %zu\n", ws_size, (size_t)WS_NEED); return; }
#if MULTI
  for (int ph = 0; ph < NSCHED; ++ph) {
    hipLaunchKernelGGL(mega, dim3(256), dim3(NT), 0, stream, p, ph, ph + 1);
  }
#else
  static int grid_blocks = 0;
  if (!grid_blocks) {
    int dev = 0, cus = 0, per_cu = 0;
    hipGetDevice(&dev);
    hipDeviceGetAttribute(&cus, hipDeviceAttributeMultiprocessorCount, dev);
    hipOccupancyMaxActiveBlocksPerMultiprocessor(&per_cu, mega, NT, 0);
    if (per_cu > 1) per_cu = 1;
    grid_blocks = cus * per_cu;
  }
  int lo = 0, hi = NSCHED;
  void* args[] = {&p, &lo, &hi};
  hipError_t e = hipLaunchCooperativeKernel((void*)mega, dim3(grid_blocks), dim3(NT), args, 0, stream);
  if (e != hipSuccess) fprintf(stderr, "cooperative launch failed: %s (grid %d)\n", hipGetErrorString(e), grid_blocks);
#endif
}
```

```cpp
#include <hip/hip_runtime.h>
#include <hip/hip_cooperative_groups.h>
#include <stdint.h>
#include <cstdio>
namespace cg = cooperative_groups;

#ifndef MULTI
#define MULTI 0
#endif

#ifdef NO_SCAN
#define U_SCAN(x) do{}while(0)
#else
#define U_SCAN(x) x
#endif
#ifdef NO_S5
#define U_S5(x) do{}while(0)
#else
#define U_S5(x) x
#endif
#ifdef NO_AS
#define U_AS(x) do{}while(0)
#else
#define U_AS(x) x
#endif
#ifdef NO_AP
#define U_AP(x) do{}while(0)
#else
#define U_AP(x) x
#endif
#ifdef NO_RP
#define U_RP(x) do{}while(0)
#else
#define U_RP(x) x
#endif
#ifdef NO_GEMM
#define U_GEMM(x) do{}while(0)
#else
#define U_GEMM(x) x
#endif
#ifdef NO_INIT
#define U_INIT(x) do{}while(0)
#else
#define U_INIT(x) x
#endif
#ifdef NO_CC
#define U_CC(x) do{}while(0)
#else
#define U_CC(x) x
#endif
#define DI __device__ __forceinline__
typedef unsigned short bfu;
using bf16x8 = __attribute__((ext_vector_type(8))) short;
using s16x4  = __attribute__((ext_vector_type(4))) short;
using f32x4  = __attribute__((ext_vector_type(4))) float;
using f32x16 = __attribute__((ext_vector_type(16))) float;

constexpr int NT = 512;
constexpr int MP = 65536, MS = 512, SP = 8192, TS = 32, SKP = 4160, SKS = 4128;
constexpr float ALPHA = 1.4142135623730951f;
constexpr float QSCALE = 0.10206207261596575f * 1.4426950408889634f;
constexpr size_t MiB = 1048576;

constexpr size_t LW_WIN = 0;
constexpr size_t LW_WQB = LW_WIN + (size_t)2048 * 1024 * 2;
constexpr size_t LW_WKV = LW_WQB + 768 * 256 * 2;
constexpr size_t LW_WGLU = LW_WKV + 768 * 128 * 2;
constexpr size_t LW_WOUT = LW_WGLU + 256 * 256 * 2;
constexpr size_t LW_WUP = LW_WOUT + 1024 * 1024 * 2;
constexpr size_t LW_WDN = LW_WUP + (size_t)4096 * 1024 * 2;
constexpr size_t LW_LORA = LW_WDN + (size_t)4096 * 1024 * 2;
constexpr size_t LW_STRIDE = 23 * MiB;
static_assert(LW_LORA + 384 * 128 * 2 <= LW_STRIDE, "weights region");
constexpr size_t OFF_X = 46 * MiB;
constexpr size_t OFF_XS = 174 * MiB;
constexpr size_t OFF_TAB = 175 * MiB;
constexpr size_t OFF_CTL = 176 * MiB;
constexpr size_t OFF_SS = 177 * MiB;
constexpr size_t OFF_P = 233 * MiB;
constexpr size_t S_QL = OFF_SS;
constexpr size_t S_KVL = S_QL + 512 * 256 * 2;
constexpr size_t S_U = S_KVL + 512 * 160 * 2;
constexpr size_t S_PR = S_U + 512 * 256 * 2;
constexpr size_t S_Q = S_PR + 512 * 1280 * 2;
constexpr size_t S_QABS = S_Q + 512 * 576 * 2;
constexpr size_t S_RW = S_QABS + 16 * 6 * 32 * 160 * 2;
constexpr size_t S_G = S_RW + 16 * 6 * 32 * 384 * 2;
constexpr size_t S_BON = S_G + 512 * 384 * 2;
constexpr size_t S_Y = S_BON + 512 * 6 * 4;
constexpr size_t S_MERGED = S_Y + 512 * 384 * 2;
constexpr size_t S_Z = S_MERGED + 512 * 1024 * 2;
constexpr size_t S_HID = S_Z + 512 * 1024 * 4;
constexpr size_t S_KCAT = S_HID + 512 * 4096 * 2;
constexpr size_t S_VT = S_KCAT + (size_t)16 * SKP * 160 * 2;
constexpr size_t S_ZS5 = S_VT + (size_t)16 * 128 * SKP * 2;
constexpr size_t S_END = S_ZS5 + 512 * 256 * 2;
static_assert(S_END <= OFF_P, "sample scratch overflow");
constexpr size_t P_QL = OFF_P;
constexpr size_t P_KVL = OFF_P + 32 * MiB;
constexpr size_t P_PR = OFF_P + 52 * MiB;
constexpr size_t P_U = OFF_P + 212 * MiB;
constexpr size_t P_Q = OFF_P + 244 * MiB;
constexpr size_t P_KB = OFF_P + 316 * MiB;
constexpr size_t P_VT = OFF_P + 388 * MiB;
constexpr size_t P_RW = OFF_P + 436 * MiB;
constexpr size_t P_G = OFF_P + 724 * MiB;
constexpr size_t P_BON = OFF_P + 772 * MiB;
constexpr size_t P_MERGED = OFF_P;
constexpr size_t P_Y = OFF_P + 128 * MiB;
constexpr size_t P_ZS5 = OFF_P + 176 * MiB;
constexpr size_t P_Z1 = OFF_P + 212 * MiB;
constexpr size_t P_HID = OFF_P;
constexpr size_t P_Z2 = OFF_P + 512 * MiB;
constexpr size_t P_SZP = OFF_P + 768 * MiB;
constexpr size_t WS_NEED = OFF_P + 776 * MiB;

constexpr size_t O_YP = 0;
constexpr size_t O_YS = 67108864;
constexpr size_t O_CKVP = O_YS + 524288;
constexpr size_t O_KRP = O_CKVP + 16777216;
constexpr size_t O_S5P = O_KRP + 4194304;
constexpr size_t O_RWP = O_S5P + 32768;
constexpr size_t O_SHP = O_RWP + 393216;
constexpr size_t O_CKVS = O_SHP + 20480;
constexpr size_t O_KRS = O_CKVS + 131072;
constexpr size_t O_S5S = O_KRS + 32768;
constexpr size_t O_RWS = O_S5S + 65536;
constexpr size_t O_SHS = O_RWS + 786432;

enum { I_XP = 0, I_XS, I_CCKV, I_CKR, I_SS5, I_SRW, I_SSH, I_WIN, I_QG, I_WQB, I_KVG, I_WKVB, I_LRE, I_LIM, I_LDT, I_BRE, I_BIM,
       I_CRE, I_CIM, I_S5D, I_WGLU, I_BGLU, I_MU, I_W0, I_WW2, I_A0, I_WA2, I_WG2, I_KK, I_KA, I_RK, I_GNG, I_GNB, I_WOUT,
       I_LN1G, I_LN1B, I_WUP, I_WDN, I_LN2G, I_LN2B };

struct Params { const float* in[40]; float* out; char* ws; int wave; int pad_; };
DI int opaque0() { int z; asm volatile("s_mov_b32 %0, 0" : "=s"(z)); return z; }
DI int lane_id() { return (int)__builtin_amdgcn_mbcnt_hi(~0u, __builtin_amdgcn_mbcnt_lo(~0u, 0u)); }
DI int ltid(const Params& p) { int t = p.wave * 64 + lane_id(); asm volatile("" : "+v"(t)); return t; }
DI Params relaunder(const Params& p) {
  Params q; const int z = opaque0();
  _Pragma("unroll") for (int i = 0; i < 40; ++i) q.in[i] = p.in[i] + z;
  q.out = p.out + z; q.ws = p.ws + z; q.wave = p.wave + z; q.pad_ = 0; return q;
}


constexpr int SHM_MAIN = 131072;
constexpr int SHM_BYTES = SHM_MAIN + 2048;

DI float bf2f(bfu x) { return __uint_as_float(((unsigned)x) << 16); }
DI bfu f2bf(float f) { __bf16 b = (__bf16)f; return __builtin_bit_cast(unsigned short, b); }
DI unsigned pack2(float a, float b) { return (unsigned)f2bf(a) | ((unsigned)f2bf(b) << 16); }

template <int CTRL> DI float dppf(float x) { return __int_as_float(__builtin_amdgcn_update_dpp(0, __float_as_int(x), CTRL, 0xF, 0xF, false)); }
DI float allred16(float x) { x += dppf<0x128>(x); x += dppf<0x124>(x); x += dppf<0x122>(x); x += dppf<0x121>(x); return x; }
DI float wave_sum(float v) {
  v = allred16(v);
  const int iv = __float_as_int(v);
  return __int_as_float(__builtin_amdgcn_readlane(iv, 0)) + __int_as_float(__builtin_amdgcn_readlane(iv, 16)) +
         __int_as_float(__builtin_amdgcn_readlane(iv, 32)) + __int_as_float(__builtin_amdgcn_readlane(iv, 48));
}
DI float sigmoidf_(float x) { return __builtin_amdgcn_rcpf(1.f + __expf(-x)); }
DI float tanhf_(float x) { return 1.f - 2.f * __builtin_amdgcn_rcpf(__expf(2.f * x) + 1.f); }
DI int crow(int reg, int h) { return (reg & 3) + 8 * (reg >> 2) + 4 * h; }

DI void tr_weight(const float* src, int K, int N, int Np, const float* scale, bfu* dst, char* shm, const int tid) {
  float* tile = (float*)shm;
  const int ntk = K / 64, ntn = Np / 64;
  for (int t = blockIdx.x; t < ntk * ntn; t += gridDim.x) {
    const int k0 = (t % ntk) * 64, n0 = (t / ntk) * 64;
    for (int e = tid; e < 4096; e += NT) {
      int r = e >> 6, c = e & 63;
      float v = 0.f;
      if (n0 + c < N) { v = src[(long)(k0 + r) * N + n0 + c]; if (scale) v *= scale[k0 + r]; }
      tile[r * 65 + c] = v;
    }
    __syncthreads();
    for (int e = tid; e < 4096; e += NT) {
      int rn = e >> 6, ck = e & 63;
      dst[(long)(n0 + rn) * K + k0 + ck] = f2bf(tile[ck * 65 + rn]);
    }
    __syncthreads();
  }
}

DI void phase_init(const Params& pin, char* shm) {
  const Params p = relaunder(pin);
  const int tid = ltid(p);
  const long gtid = (long)blockIdx.x * NT + tid, gsz = (long)gridDim.x * NT;
  if (blockIdx.x == 0) for (int i = tid; i < 1024; i += NT) ((unsigned*)(p.ws + OFF_CTL))[i] = 0u;
  float2* tab = (float2*)(p.ws + OFF_TAB);
  for (long i = gtid; i < 8192 * 16; i += gsz) {
    int pos = (int)(i >> 4), k = (int)(i & 15);
    const float inv = exp2f(-(float)k * 0.8304820237218406f);
    const float ang = (float)pos * inv;
    const float s = sinf(ang), c = cosf(ang);
    tab[i] = make_float2(c, s);
  }
  for (int l = 0; l < 2; ++l) {
    char* wb = p.ws + l * LW_STRIDE;
    tr_weight(p.in[I_WIN] + (size_t)l * 1024 * 1952, 1024, 1952, 2048, nullptr, (bfu*)(wb + LW_WIN), shm, tid);
    tr_weight(p.in[I_WQB] + (size_t)l * 256 * 576, 256, 576, 768, p.in[I_QG] + l * 256, (bfu*)(wb + LW_WQB), shm, tid);
    tr_weight(p.in[I_WKVB] + (size_t)l * 128 * 768, 128, 768, 768, p.in[I_KVG] + l * 128, (bfu*)(wb + LW_WKV), shm, tid);
    tr_weight(p.in[I_WGLU] + (size_t)l * 256 * 256, 256, 256, 256, nullptr, (bfu*)(wb + LW_WGLU), shm, tid);
    tr_weight(p.in[I_WOUT] + (size_t)l * 1024 * 1024, 1024, 1024, 1024, nullptr, (bfu*)(wb + LW_WOUT), shm, tid);
    tr_weight(p.in[I_WUP] + (size_t)l * 1024 * 4096, 1024, 4096, 4096, nullptr, (bfu*)(wb + LW_WUP), shm, tid);
    tr_weight(p.in[I_WDN] + (size_t)l * 4096 * 1024, 4096, 1024, 1024, nullptr, (bfu*)(wb + LW_WDN), shm, tid);
    { bfu* WL = (bfu*)(wb + LW_LORA);
      const float* W2 = p.in[I_WW2] + (size_t)l * 32 * 384, *A2 = p.in[I_WA2] + (size_t)l * 32 * 384, *G2 = p.in[I_WG2] + (size_t)l * 64 * 384;
      for (long i = gtid; i < 384 * 128; i += gsz) { const int n = (int)(i >> 7), k = (int)(i & 127);
        const float v = (k < 32) ? W2[k * 384 + n] : (k < 64 ? A2[(k - 32) * 384 + n] : G2[(k - 64) * 384 + n]);
        WL[i] = f2bf(v); } }
  }
  {
    const float4* xp = (const float4*)p.in[I_XP]; uint2* X = (uint2*)(p.ws + OFF_X);
    for (long i = gtid; i < (long)MP * 256; i += gsz) { float4 v = xp[i]; X[i] = make_uint2(pack2(v.x, v.y), pack2(v.z, v.w)); }
    const float4* xs = (const float4*)p.in[I_XS]; uint2* XS = (uint2*)(p.ws + OFF_XS);
    for (long i = gtid; i < (long)MS * 256; i += gsz) { float4 v = xs[i]; XS[i] = make_uint2(pack2(v.x, v.y), pack2(v.z, v.w)); }
  }
}

constexpr int BM = 256, BK = 64, HALF = 128, NXCD = 8, WGM = 8, HT = HALF * BK;
DI int lds_byte(int r, int c) {
  int st = (r >> 4) * 2 + (c >> 5), rr = r & 15, cc = c & 31, ob = rr * 64 + cc * 2;
  return st * 1024 + (ob ^ (((ob >> 9) & 1) << 5));
}
DI void stage_rc(int b, int& R, int& C) {
  int st = b / 1024, sb = b % 1024, swz = sb ^ (((sb >> 9) & 1) << 5);
  R = (st >> 1) * 16 + swz / 64; C = (st & 1) * 32 + (swz % 64) / 2;
}
enum { K_PROJ = 0, K_Q, K_KV, K_GLU, K_RES1, K_UP, K_RES2 };
struct Job { const bfu* A; const bfu* Bt; int lda, ldb, M, N, K, kind, samp, split; };

DI void gemm_tile(const bfu* A, const bfu* Bt, const int lda, const int ldb, const int K, const int brow, const int bcol,
                  bfu* shm, f32x4 (&acc)[2][2][4][2], const int tidg, const bool pre) {
#define SA(b, h) (shm + ((b) * 2 + (h)) * HT)
#define SB(b, h) (shm + (4 + (b) * 2 + (h)) * HT)
#define STAGE(P, BASE, LD, OFF, br, kt) do { const char* _gb = (const char*)((BASE) + ((long)(br) * (LD) + (long)(kt) * BK)); \
    asm volatile("" : "+s"(_gb)); \
    _Pragma("unroll") for (int _i = 0; _i < 2; ++_i) { \
      __builtin_amdgcn_global_load_lds((const unsigned*)(_gb + (long)_i * 128 * (LD) + OFF), \
        (__attribute__((address_space(3))) unsigned*)((char*)(P) + wv1024 + _i * 8192), 16, 0, 0); } } while (0)
#define LDA(dst, b, h) _Pragma("unroll") for (int m = 0; m < 4; ++m) _Pragma("unroll") for (int k = 0; k < 2; ++k) \
    dst[m][k] = *reinterpret_cast<const bf16x8*>((const char*)SA(b, h) + la + (m * 2048 + k * 1024))
#define LDB(dst, b, h) _Pragma("unroll") for (int n = 0; n < 2; ++n) _Pragma("unroll") for (int k = 0; k < 2; ++k) \
    dst[n][k] = *reinterpret_cast<const bf16x8*>((const char*)SB(b, h) + lb + (n * 2048 + k * 1024))
#define MMA(ai, bj, At, Bx) do { __builtin_amdgcn_s_setprio(1); \
    _Pragma("unroll") for (int m = 0; m < 4; ++m) _Pragma("unroll") for (int n = 0; n < 2; ++n) _Pragma("unroll") for (int k = 0; k < 2; ++k) \
      acc[ai][bj][m][n] = __builtin_amdgcn_mfma_f32_16x16x32_bf16(At[m][k], Bx[n][k], acc[ai][bj][m][n], 0, 0, 0); \
    __builtin_amdgcn_s_setprio(0); } while (0)
#define WAIT_V(n) asm volatile("s_waitcnt vmcnt(" #n ")" ::: "memory")
#define WAIT_L(n) asm volatile("s_waitcnt lgkmcnt(" #n ")" ::: "memory")
#define BAR __builtin_amdgcn_s_barrier()
#define SCHED __builtin_amdgcn_sched_barrier(0)
  const int tb16 = tidg * 16;
  const int wv1024 = __builtin_amdgcn_readfirstlane(tidg >> 6) * 1024;
  const int wid = tidg >> 6, lane = tidg & 63, wr = wid >> 2, wc = wid & 3, fr = lane & 15, fq = lane >> 4;
  _Pragma("unroll") for (int a = 0; a < 2; ++a) _Pragma("unroll") for (int b = 0; b < 2; ++b) _Pragma("unroll") for (int m = 0; m < 4; ++m) _Pragma("unroll") for (int n = 0; n < 2; ++n) acc[a][b][m][n] = f32x4{0.f, 0.f, 0.f, 0.f};
  bf16x8 At[4][2], B0[2][2], B1[2][2];
  const int nt = K / BK;
  unsigned aoff, boff;
  { int _r, _c; stage_rc(tb16, _r, _c); aoff = (unsigned)(_r * lda + _c) * 2u; boff = (unsigned)(_r * ldb + _c) * 2u; }
  const int sw_ = (fr * 64 + fq * 16) ^ ((((fr * 64 + fq * 16) >> 9) & 1) << 5);
  const int la = wr * 8192 + sw_, lb = wc * 4096 + sw_;
  if (!pre) {
    STAGE(SB(0, 0), Bt, ldb, boff, bcol, 0); STAGE(SA(0, 0), A, lda, aoff, brow, 0);
    STAGE(SB(0, 1), Bt, ldb, boff, bcol + HALF, 0); STAGE(SA(0, 1), A, lda, aoff, brow + HALF, 0);
    if (wr == 1) BAR;
    WAIT_V(4); BAR;
    STAGE(SB(1, 0), Bt, ldb, boff, bcol, 1); STAGE(SA(1, 0), A, lda, aoff, brow, 1); STAGE(SB(1, 1), Bt, ldb, boff, bcol + HALF, 1);
    WAIT_V(6); BAR;
  } else {
    WAIT_V(0);
    if (wr == 1) BAR;
    BAR; BAR;
  }
  for (int t = 0; t < nt - 2; t += 2) {
    LDB(B0, 0, 0); SCHED; LDA(At, 0, 0); STAGE(SA(1, 1), A, lda, aoff, brow + HALF, t + 1);
    WAIT_L(8); BAR; WAIT_L(0); MMA(0, 0, At, B0); BAR; SCHED;
    LDB(B1, 0, 1); STAGE(SB(0, 0), Bt, ldb, boff, bcol, t + 2);
    BAR; WAIT_L(0); MMA(0, 1, At, B1); BAR;
    LDA(At, 0, 1); STAGE(SA(0, 0), A, lda, aoff, brow, t + 2);
    BAR; WAIT_L(0); MMA(1, 0, At, B0); BAR; SCHED;
    STAGE(SB(0, 1), Bt, ldb, boff, bcol + HALF, t + 2);
    WAIT_V(6); BAR; MMA(1, 1, At, B1); BAR;
    LDB(B0, 1, 0); SCHED; LDA(At, 1, 0); STAGE(SA(0, 1), A, lda, aoff, brow + HALF, t + 2);
    WAIT_L(8); BAR; WAIT_L(0); MMA(0, 0, At, B0); BAR; SCHED;
    LDB(B1, 1, 1); STAGE(SB(1, 0), Bt, ldb, boff, bcol, t + 3);
    BAR; WAIT_L(0); MMA(0, 1, At, B1); BAR;
    LDA(At, 1, 1); STAGE(SA(1, 0), A, lda, aoff, brow, t + 3);
    BAR; WAIT_L(0); MMA(1, 0, At, B0); BAR; SCHED;
    STAGE(SB(1, 1), Bt, ldb, boff, bcol + HALF, t + 3);
    WAIT_V(6); BAR; MMA(1, 1, At, B1); BAR;
  }
  { LDB(B0, 0, 0); LDA(At, 0, 0); STAGE(SA(1, 1), A, lda, aoff, brow + HALF, nt - 1);
    BAR; WAIT_L(0); MMA(0, 0, At, B0); BAR;
    LDB(B1, 0, 1); BAR; WAIT_L(0); MMA(0, 1, At, B1); BAR;
    LDA(At, 0, 1); WAIT_V(4); BAR; WAIT_L(0); MMA(1, 0, At, B0); MMA(1, 1, At, B1); BAR; }
  { LDB(B0, 1, 0); LDA(At, 1, 0); WAIT_V(2); BAR; WAIT_L(0); MMA(0, 0, At, B0); BAR;
    LDB(B1, 1, 1); WAIT_V(0); BAR; WAIT_L(0); MMA(0, 1, At, B1); BAR;
    LDA(At, 1, 1); BAR; WAIT_L(0); MMA(1, 0, At, B0); MMA(1, 1, At, B1); BAR; }
  if (wr == 0) BAR;
}
DI void gemm_issue(const bfu* A, const bfu* Bt, const int lda, const int ldb, const int brow, const int bcol, bfu* shm, const int tidg) {
  const int tb16 = tidg * 16;
  const int wv1024 = __builtin_amdgcn_readfirstlane(tidg >> 6) * 1024;
  unsigned aoff, boff;
  { int _r, _c; stage_rc(tb16, _r, _c); aoff = (unsigned)(_r * lda + _c) * 2u; boff = (unsigned)(_r * ldb + _c) * 2u; }
  STAGE(SB(0, 0), Bt, ldb, boff, bcol, 0); STAGE(SA(0, 0), A, lda, aoff, brow, 0);
  STAGE(SB(0, 1), Bt, ldb, boff, bcol + HALF, 0); STAGE(SA(0, 1), A, lda, aoff, brow + HALF, 0);
  STAGE(SB(1, 0), Bt, ldb, boff, bcol, 1); STAGE(SA(1, 0), A, lda, aoff, brow, 1); STAGE(SB(1, 1), Bt, ldb, boff, bcol + HALF, 1);
}

template <class F>
DI void epi_loop(f32x4 (&acc)[2][2][4][2], int wr, int wc, int fq, F f) {
  _Pragma("unroll") for (int ai = 0; ai < 2; ++ai) _Pragma("unroll") for (int bj = 0; bj < 2; ++bj) _Pragma("unroll") for (int m = 0; m < 4; ++m)
    f(ai * 128 + wr * 64 + m * 16 + fq * 4, bj * 128 + wc * 32, acc[ai][bj][m][0], acc[ai][bj][m][1]);
}

DI f32x4 quad_tr(f32x4 v, const bool o1, const bool o2) {
  const float s0 = o1 ? v[0] : v[1], s1 = o1 ? v[2] : v[3];
  const float r0 = dppf<0xB1>(s0), r1 = dppf<0xB1>(s1);
  if (o1) { v[0] = r0; v[2] = r1; } else { v[1] = r0; v[3] = r1; }
  const float t0 = o2 ? v[0] : v[2], t1 = o2 ? v[1] : v[3];
  const float q0 = dppf<0x4E>(t0), q1 = dppf<0x4E>(t1);
  if (o2) { v[0] = q0; v[1] = q1; } else { v[2] = q0; v[3] = q1; }
  return v;
}

DI void gemm_epilogue(const Params& pin, const Job& jb, int layer, int brow, int bcol, f32x4 (&acc)[2][2][4][2], const float* rs) {
  const Params p = relaunder(pin);
  const int tide = ltid(p);
  const int wid = tide >> 6, lane = tide & 63, wr = wid >> 2, wc = wid & 3, fr = lane & 15, fq = lane >> 4;
  const int samp = jb.samp, T = samp ? TS : SP, LT = samp ? 5 : 13, kind = jb.kind;
  const bool o1 = lane & 1, o2 = lane & 2; const int fl = fr & 3, fc = fr & 12;
  char* ws = p.ws;
  if (kind == K_PROJ) {
    bfu* QL = (bfu*)(ws + (samp ? S_QL : P_QL)); bfu* KVL = (bfu*)(ws + (samp ? S_KVL : P_KVL));
    bfu* U = (bfu*)(ws + (samp ? S_U : P_U)); bfu* PR = (bfu*)(ws + (samp ? S_PR : P_PR));
    float* osh = p.out + (samp ? O_SHS : O_SHP) + (size_t)layer * (samp ? 16 : 8) * 1280;
    epi_loop(acc, wr, wc, fq, [&](int rl, int cbl, const f32x4& v0, const f32x4& v1) {
      const int r = brow + rl + fl;
      _Pragma("unroll") for (int n = 0; n < 2; ++n) {
        const f32x4 v = quad_tr(n ? v1 : v0, o1, o2);
        const int c = bcol + cbl + n * 16 + fc;
        const uint2 pk = make_uint2(pack2(v[0], v[1]), pack2(v[2], v[3]));
        if (c < 256) *(uint2*)(QL + (long)r * 256 + c) = pk;
        else if (c < 416) *(uint2*)(KVL + (long)r * 160 + (c - 256)) = pk;
        else if (c < 672) *(uint2*)(U + (long)r * 256 + (c - 416)) = pk;
        else if (c < 1952) {
          *(uint2*)(PR + (long)r * 1280 + (c - 672)) = pk;
          if ((r & (T - 1)) == T - 1) *(float4*)(osh + (size_t)(r >> LT) * 1280 + (c - 672)) = make_float4(v[0], v[1], v[2], v[3]);
        }
      }
    });
  } else if (kind == K_KV) {
    bfu* KB = (bfu*)(ws + P_KB); bfu* VT = (bfu*)(ws + P_VT);
    epi_loop(acc, wr, wc, fq, [&](int rl, int cbl, const f32x4& v0, const f32x4& v1) {
      const int r0 = brow + rl; const int b = r0 >> 13, t0 = r0 & (SP - 1);
      const int cg16 = bcol + cbl; const int h = cg16 >> 7;
      if ((cg16 & 64) == 0) {
        const float s = rs[rl + fl];
        _Pragma("unroll") for (int n = 0; n < 2; ++n) {
          const f32x4 v = quad_tr(n ? v1 : v0, o1, o2);
          const int w = (cg16 & 127) + n * 16 + fc;
          *(uint2*)(KB + ((long)(b * 6 + h) * SP + t0 + fl) * 96 + w) = make_uint2(pack2(v[0] * s, v[1] * s), pack2(v[2] * s, v[3] * s));
        }
      } else {
        const float s0 = rs[rl], s1 = rs[rl + 1], s2 = rs[rl + 2], s3 = rs[rl + 3];
        _Pragma("unroll") for (int n = 0; n < 2; ++n) {
          const f32x4 v = n ? v1 : v0;
          const int w = (cg16 & 63) + n * 16 + fr;
          *(uint2*)(VT + ((long)(b * 6 + h) * 64 + w) * SP + t0) = make_uint2(pack2(v[0] * s0, v[1] * s1), pack2(v[2] * s2, v[3] * s3));
        }
      }
    });
  } else if (kind == K_GLU) {
    const bfu* U = (const bfu*)(ws + (samp ? S_ZS5 : P_ZS5)); bfu* MG = (bfu*)(ws + (samp ? S_MERGED : P_MERGED));
    const float* bgl = p.in[I_BGLU] + layer * 256;
    epi_loop(acc, wr, wc, fq, [&](int rl, int cbl, const f32x4& v0, const f32x4& v1) {
      const long r = brow + rl + fl;
      _Pragma("unroll") for (int n = 0; n < 2; ++n) {
        const f32x4 v = quad_tr(n ? v1 : v0, o1, o2);
        const int c = bcol + cbl + n * 16 + fc;
        const float4 bg = *(const float4*)(bgl + c);
        const uint2 zu = *(const uint2*)(U + r * 256 + c);
        const float z0 = bf2f(zu.x & 0xffff), z1 = bf2f(zu.x >> 16), z2 = bf2f(zu.y & 0xffff), z3 = bf2f(zu.y >> 16);
        *(uint2*)(MG + r * 1024 + 384 + c) = make_uint2(pack2(z0 * sigmoidf_(v[0] + bg.x), z1 * sigmoidf_(v[1] + bg.y)),
                                                        pack2(z2 * sigmoidf_(v[2] + bg.z), z3 * sigmoidf_(v[3] + bg.w)));
      }
    });
  } else if (kind == K_RES1 || kind == K_RES2) {
    float* Z = samp ? (float*)(ws + P_SZP) + (size_t)jb.split * 512 * 1024 : (float*)(ws + (kind == K_RES1 ? P_Z1 : P_Z2));
    const bfu* X = (const bfu*)(ws + (samp ? OFF_XS : OFF_X));
    const float al = (samp && jb.split != 0) ? 0.f : ALPHA;
    epi_loop(acc, wr, wc, fq, [&](int rl, int cbl, const f32x4& v0, const f32x4& v1) {
      const long r = brow + rl + fl;
      _Pragma("unroll") for (int n = 0; n < 2; ++n) {
        const f32x4 v = quad_tr(n ? v1 : v0, o1, o2);
        const int c = bcol + cbl + n * 16 + fc;
        const uint2 xu = *(const uint2*)(X + r * 1024 + c);
        *(float4*)(Z + r * 1024 + c) = make_float4(al * bf2f(xu.x & 0xffff) + v[0], al * bf2f(xu.x >> 16) + v[1],
                                                   al * bf2f(xu.y & 0xffff) + v[2], al * bf2f(xu.y >> 16) + v[3]);
      }
    });
  } else if (kind == K_UP) {
    bfu* H = (bfu*)(ws + (samp ? S_HID : P_HID));
    epi_loop(acc, wr, wc, fq, [&](int rl, int cbl, const f32x4& v0, const f32x4& v1) {
      const long r = brow + rl + fl;
      _Pragma("unroll") for (int n = 0; n < 2; ++n) {
        const f32x4 v = quad_tr(n ? v1 : v0, o1, o2);
        const int c = bcol + cbl + n * 16 + fc;
        const float x0 = fmaxf(v[0], 0.f), x1 = fmaxf(v[1], 0.f), x2 = fmaxf(v[2], 0.f), x3 = fmaxf(v[3], 0.f);
        *(uint2*)(H + r * 4096 + c) = make_uint2(pack2(x0 * x0, x1 * x1), pack2(x2 * x2, x3 * x3));
      }
    });
  } else {
    bfu* Q = (bfu*)(ws + (samp ? S_Q : P_Q));
    const float2* tab = (const float2*)(ws + OFF_TAB);
    epi_loop(acc, wr, wc, fq, [&](int rl, int cbl, const f32x4& v0, const f32x4& v1) {
      const int cb = bcol + cbl;
      if (cb < 576) {
        const int r = brow + rl + fl; const float s = rs[rl + fl];
        const bool rope = (cb % 96) == 64;
        f32x4 a = quad_tr(v0, o1, o2), b = quad_tr(v1, o1, o2);
        _Pragma("unroll") for (int k = 0; k < 4; ++k) { a[k] *= s; b[k] *= s; }
        if (rope) { const int pos = (r & (T - 1)) + (samp ? 4096 : 0);
          _Pragma("unroll") for (int k = 0; k < 4; ++k) { const float2 cs = tab[pos * 16 + fc + k];
            const float a2 = a[k] * cs.x - b[k] * cs.y, b2 = b[k] * cs.x + a[k] * cs.y; a[k] = a2; b[k] = b2; } }
        *(uint2*)(Q + (long)r * 576 + cb + fc) = make_uint2(pack2(a[0], a[1]), pack2(a[2], a[3]));
        *(uint2*)(Q + (long)r * 576 + cb + 16 + fc) = make_uint2(pack2(b[0], b[1]), pack2(b[2], b[3]));
      }
    });
  }
}

DI Job get_job(const Params& pin, int kind, int layer, int samp, int split) {
  const Params p = relaunder(pin);
  char* ws = p.ws; char* wb = ws + layer * LW_STRIDE;
  Job j; j.kind = kind; j.samp = samp; j.M = samp ? MS : MP; j.split = split;
  switch (kind) {
    case K_PROJ: j.A = (const bfu*)(ws + (samp ? OFF_XS : OFF_X)); j.lda = 1024; j.Bt = (const bfu*)(wb + LW_WIN); j.ldb = 1024; j.N = 2048; j.K = 1024; break;
    case K_Q: j.A = (const bfu*)(ws + (samp ? S_QL : P_QL)); j.lda = 256; j.Bt = (const bfu*)(wb + LW_WQB); j.ldb = 256; j.N = 768; j.K = 256; break;
    case K_KV: j.A = (const bfu*)(ws + P_KVL); j.lda = 160; j.Bt = (const bfu*)(wb + LW_WKV); j.ldb = 128; j.N = 768; j.K = 128; break;
    case K_GLU: j.A = (const bfu*)(ws + (samp ? S_ZS5 : P_ZS5)); j.lda = 256; j.Bt = (const bfu*)(wb + LW_WGLU); j.ldb = 256; j.N = 256; j.K = 256; break;
    case K_RES1: j.A = (const bfu*)(ws + (samp ? S_MERGED : P_MERGED)); j.lda = 1024; j.Bt = (const bfu*)(wb + LW_WOUT); j.ldb = 1024; j.N = 1024; j.K = 1024; break;
    case K_UP: j.A = (const bfu*)(ws + (samp ? OFF_XS : OFF_X)); j.lda = 1024; j.Bt = (const bfu*)(wb + LW_WUP); j.ldb = 1024; j.N = 4096; j.K = 1024; break;
    default: j.A = (const bfu*)(ws + (samp ? S_HID : P_HID)); j.lda = 4096; j.Bt = (const bfu*)(wb + LW_WDN); j.ldb = 4096; j.N = 1024; j.K = 4096; break;
  }
  if (samp && (kind == K_RES1 || kind == K_RES2)) { j.K /= 4; j.A += split * j.K; j.Bt += split * j.K; }
  return j;
}

DI void tile_coords(const Job& jb, int wgid, int& brow, int& bcol) {
  const int nM = jb.M / BM, nN = jb.N / BM, nwg = nM * nN;
  if (jb.kind == K_RES2 && !jb.samp) wgid = nwg - 1 - wgid;
  { int q = nwg / NXCD, r = nwg % NXCD, xcd = wgid % NXCD, off = wgid / NXCD;
    wgid = (xcd < r ? xcd * (q + 1) : r * (q + 1) + (xcd - r) * q) + off; }
  const int nig = WGM * nN, gid = wgid / nig, fm = gid * WGM, gsz = min(nM - fm, WGM);
  const int pm = fm + ((wgid % nig) % gsz), pn = (wgid % nig) / gsz; brow = pm * BM; bcol = pn * BM;
}
DI void gemm_do_tile(const Params& pin, const Job& jb, int layer, int brow, int bcol, bool pre, bool hasn, const Job& nj, int nbrow, int nbcol, char* shm) {
  const Params p = relaunder(pin);
  f32x4 acc[2][2][4][2];
  const int tg = ltid(p);
  gemm_tile(jb.A, jb.Bt, jb.lda, jb.ldb, jb.K, brow, bcol, (bfu*)shm, acc, tg, pre);
  if (hasn) gemm_issue(nj.A, nj.Bt, nj.lda, nj.ldb, nbrow, nbcol, (bfu*)shm, tg);
  float* rs = (float*)(shm + SHM_MAIN);
  if (jb.kind == K_Q || jb.kind == K_KV) {
    const int tid = ltid(p), row = tid >> 1, half = tid & 1, kh = jb.K / 2;
    const bfu* ap = jb.A + (long)(brow + row) * jb.lda + half * kh;
    float ss = 0.f;
    for (int i = 0; i < kh; i += 8) { uint4 u = *(const uint4*)(ap + i);
      unsigned w[4] = {u.x, u.y, u.z, u.w};
      _Pragma("unroll") for (int k = 0; k < 4; ++k) { float a = bf2f(w[k] & 0xffff), b = bf2f(w[k] >> 16); ss += a * a + b * b; } }
    ss += __shfl_xor(ss, 1);
    float inv = rsqrtf(ss / (float)jb.K + 1e-6f);
    if (jb.kind == K_Q) inv *= QSCALE;
    if (half == 0) rs[row] = inv;
  }
  __syncthreads();
  gemm_epilogue(p, jb, layer, brow, bcol, acc, rs);
  __syncthreads();
}

DI void ln_rows(const Params& pin, int layer, int which  , int final_) {
  const Params p = relaunder(pin);
  const int tidw = ltid(p); const int wave = tidw >> 6, lane = tidw & 63;
  const float* g = p.in[which ? I_LN2G : I_LN1G] + layer * 1024;
  const float* bta = p.in[which ? I_LN2B : I_LN1B] + layer * 1024;
  for (int rr0 = (blockIdx.x * 8 + wave) * 2; rr0 < MP + MS; rr0 += gridDim.x * 16) {
    const int row0 = MP + MS - 2 - rr0;
    float4 v[2][4]; float s[2];
    _Pragma("unroll") for (int q = 0; q < 2; ++q) {
      const int row = row0 + q; const int samp = row >= MP; const long r = samp ? row - MP : row;
      const float* Z = (const float*)(p.ws + (samp ? P_SZP : (which ? P_Z2 : P_Z1))) + r * 1024;
      s[q] = 0.f;
      _Pragma("unroll") for (int k = 0; k < 4; ++k) {
        float4 a = *(const float4*)(Z + k * 256 + lane * 4);
        if (samp) { _Pragma("unroll") for (int sp = 1; sp < 4; ++sp) { const float4 b = *(const float4*)(Z + (size_t)sp * 512 * 1024 + k * 256 + lane * 4);
          a.x += b.x; a.y += b.y; a.z += b.z; a.w += b.w; } }
        v[q][k] = a; s[q] += a.x + a.y + a.z + a.w; }
    }
    _Pragma("unroll") for (int q = 0; q < 2; ++q) {
      const int row = row0 + q; const int samp = row >= MP; const long r = samp ? row - MP : row;
      const float mu = wave_sum(s[q]) * (1.f / 1024);
      float qq = 0.f;
      _Pragma("unroll") for (int k = 0; k < 4; ++k) { float a = v[q][k].x - mu, b = v[q][k].y - mu, c = v[q][k].z - mu, d = v[q][k].w - mu; qq += a * a + b * b + c * c + d * d; }
      const float rstd = rsqrtf(wave_sum(qq) * (1.f / 1024) + 1e-5f);
      bfu* X = (bfu*)(p.ws + (samp ? OFF_XS : OFF_X)) + r * 1024;
      float* O = p.out + (samp ? O_YS : O_YP) + r * 1024;
      _Pragma("unroll") for (int k = 0; k < 4; ++k) {
        const int c = k * 256 + lane * 4;
        const float4 gg = *(const float4*)(g + c), bb = *(const float4*)(bta + c);
        const float o0 = (v[q][k].x - mu) * rstd * gg.x + bb.x, o1 = (v[q][k].y - mu) * rstd * gg.y + bb.y;
        const float o2 = (v[q][k].z - mu) * rstd * gg.z + bb.z, o3 = (v[q][k].w - mu) * rstd * gg.w + bb.w;
        if (final_) *(float4*)(O + c) = make_float4(o0, o1, o2, o3);
        else *(uint2*)(X + c) = make_uint2(pack2(o0, o1), pack2(o2, o3));
      }
    }
  }
}

DI void mla_prep_unit(const Params& pin, int layer, int samp, int unit) {
  const Params p = relaunder(pin);
  const int tidw = ltid(p); const int wave = tidw >> 6, lane = tidw & 63;
  const int T = samp ? TS : SP;
  const bfu* KVL = (const bfu*)(p.ws + (samp ? S_KVL : P_KVL));
  const float2* tab = (const float2*)(p.ws + OFF_TAB);
  const float g0 = p.in[I_KVG][layer * 128 + 2 * lane], g1 = p.in[I_KVG][layer * 128 + 2 * lane + 1];
  unsigned prv[8];
  _Pragma("unroll") for (int i = 0; i < 8; ++i) prv[i] = *(const unsigned*)(KVL + (long)(unit * 64 + i * 8 + wave) * 160 + lane * 2);
  _Pragma("unroll") for (int i = 0; i < 8; ++i) {
    const int r = unit * 64 + i * 8 + wave; const int b = r / T, t = r % T;
    const unsigned pr = prv[i];
    float x0 = bf2f(pr & 0xffff), x1 = bf2f(pr >> 16);
    float ss = wave_sum(x0 * x0 + x1 * x1);
    float inv = rsqrtf(ss * (1.f / 128) + 1e-6f);
    float c0 = x0 * inv * g0, c1 = x1 * inv * g1;
    if (!samp) {
      *(float2*)(p.out + O_CKVP + ((size_t)(layer * 8 + b) * SP + t) * 128 + 2 * lane) = make_float2(c0, c1);
    } else {
      *(float2*)(p.out + O_CKVS + ((size_t)(layer * 16 + b) * TS + t) * 128 + 2 * lane) = make_float2(c0, c1);
      bfu* KC = (bfu*)(p.ws + S_KCAT); bfu* VT = (bfu*)(p.ws + S_VT);
      *(unsigned*)(KC + ((long)b * SKP + 4096 + t) * 160 + 2 * lane) = pack2(c0, c1);
      VT[((long)b * 128 + 2 * lane) * SKP + 4096 + t] = f2bf(c0);
      VT[((long)b * 128 + 2 * lane + 1) * SKP + 4096 + t] = f2bf(c1);
    }
    if (lane < 16) {
      float xa = bf2f(KVL[(long)r * 160 + 128 + lane]), xb = bf2f(KVL[(long)r * 160 + 144 + lane]);
      const int pos = t + (samp ? 4096 : 0);
      float2 cs = tab[pos * 16 + lane];
      float o1 = xa * cs.x - xb * cs.y, o2 = xb * cs.x + xa * cs.y;
      if (!samp) {
        float* o = p.out + O_KRP + ((size_t)(layer * 8 + b) * SP + t) * 32; o[lane] = o1; o[lane + 16] = o2;
        bfu* KB = (bfu*)(p.ws + P_KB);
        for (int h = 0; h < 6; ++h) { bfu* kr = KB + ((long)(b * 6 + h) * SP + t) * 96 + 64; kr[lane] = f2bf(o1); kr[lane + 16] = f2bf(o2); }
      } else {
        float* o = p.out + O_KRS + ((size_t)(layer * 16 + b) * TS + t) * 32; o[lane] = o1; o[lane + 16] = o2;
        bfu* kr = (bfu*)(p.ws + S_KCAT) + ((long)b * SKP + 4096 + t) * 160 + 128; kr[lane] = f2bf(o1); kr[lane + 16] = f2bf(o2);
      }
    }
  }
}

DI void cache_conv_unit(const Params& pin, int layer, int unit, char* shm) {
  const Params p = relaunder(pin);
  const int tid = ltid(p), b = unit >> 6, t0 = (unit & 63) * 64;
  const float* ck = p.in[I_CCKV] + ((size_t)(layer * 16 + b) * 4096 + t0) * 128;
  const float* kr = p.in[I_CKR] + ((size_t)(layer * 16 + b) * 4096 + t0) * 32;
  bfu* KC = (bfu*)(p.ws + S_KCAT) + ((long)b * SKP + t0) * 160; bfu* VT = (bfu*)(p.ws + S_VT) + (long)b * 128 * SKP + t0;
  bfu* tl = (bfu*)shm;
  _Pragma("unroll") for (int i = 0; i < 4; ++i) { int e = tid + i * NT, tok = e >> 5, c4 = (e & 31) * 4;
    float4 v = *(const float4*)(ck + tok * 128 + c4);
    *(uint2*)(KC + (long)tok * 160 + c4) = make_uint2(pack2(v.x, v.y), pack2(v.z, v.w));
    tl[(c4 + 0) * 72 + tok] = f2bf(v.x); tl[(c4 + 1) * 72 + tok] = f2bf(v.y); tl[(c4 + 2) * 72 + tok] = f2bf(v.z); tl[(c4 + 3) * 72 + tok] = f2bf(v.w); }
  _Pragma("unroll") for (int i = 0; i < 4; ++i) { int e = tid + i * NT, tok = e >> 5, c = e & 31; KC[(long)tok * 160 + 128 + c] = f2bf(kr[tok * 32 + c]); }
  __syncthreads();
  _Pragma("unroll") for (int i = 0; i < 2; ++i) { int e = tid + i * NT, c = e >> 3, part = e & 7;
    *(uint4*)(VT + (long)c * SKP + part * 8) = *(const uint4*)(tl + c * 72 + part * 8); }
  __syncthreads();
}

DI void rwkv_prep_unit(const Params& pin, int layer, int samp, int unit, char* shm) {
  const Params p = relaunder(pin);
  const int tid = ltid(p), wave = tid >> 6, lane = tid & 63;
  const int T = samp ? TS : SP; const int r0 = unit * 32, b = r0 / T, t0 = r0 % T;
  const bfu* PR = (const bfu*)(p.ws + (samp ? S_PR : P_PR));
  const float* mu = p.in[I_MU] + layer * 1280;
  const float* sh0 = samp ? p.in[I_SSH] + (size_t)(layer * 16 + b) * 1280 : nullptr;
  bfu* lorb = (bfu*)shm;
  bfu* prt = (bfu*)(shm + 16384);
  for (int e = tid; e < 4096; e += NT) {
    const int tk = e >> 7, c = e & 127, col = 1152 + c;
    const float cur = bf2f(PR[(long)(r0 + tk) * 1280 + col]);
    const float prev = (t0 + tk == 0) ? (sh0 ? sh0[col] : 0.f) : bf2f(PR[(long)(r0 + tk - 1) * 1280 + col]);
    const float ps = cur + (prev - cur) * mu[col];
    lorb[tk * 136 + c] = f2bf((c < 32) ? tanhf_(ps) : (c < 64 ? ps : sigmoidf_(ps)));
  }
  for (int e = tid; e < 33 * 144; e += NT) {
    const int row = e / 144, c8 = e - row * 144;
    if (row > 0 || t0 > 0) *(uint4*)(prt + row * 1152 + c8 * 8) = *(const uint4*)(PR + (long)(r0 - 1 + row) * 1280 + c8 * 8);
  }
  __syncthreads();
  if (wave < 6) {
    const int h = wave, n16 = lane & 15, kg = lane >> 4;
    const bfu* WL = (const bfu*)(p.ws + layer * LW_STRIDE + LW_LORA);
    f32x4 aW[2][4], aA[2][4], aG[2][4];
    {
      bf16x8 Af[2][4];
      _Pragma("unroll") for (int mt = 0; mt < 2; ++mt) _Pragma("unroll") for (int s = 0; s < 4; ++s)
        Af[mt][s] = *(const bf16x8*)(lorb + (mt * 16 + n16) * 136 + 32 * s + 8 * kg);
      _Pragma("unroll") for (int nt = 0; nt < 4; ++nt) {
        const bfu* wrow = WL + (long)(h * 64 + nt * 16 + n16) * 128 + 8 * kg;
        const bf16x8 B0 = *(const bf16x8*)(wrow), B1 = *(const bf16x8*)(wrow + 32), B2 = *(const bf16x8*)(wrow + 64), B3 = *(const bf16x8*)(wrow + 96);
        _Pragma("unroll") for (int mt = 0; mt < 2; ++mt) {
          const f32x4 z = {0.f, 0.f, 0.f, 0.f};
          aW[mt][nt] = __builtin_amdgcn_mfma_f32_16x16x32_bf16(Af[mt][0], B0, z, 0, 0, 0);
          aA[mt][nt] = __builtin_amdgcn_mfma_f32_16x16x32_bf16(Af[mt][1], B1, z, 0, 0, 0);
          aG[mt][nt] = __builtin_amdgcn_mfma_f32_16x16x32_bf16(Af[mt][2], B2, z, 0, 0, 0);
          aG[mt][nt] = __builtin_amdgcn_mfma_f32_16x16x32_bf16(Af[mt][3], B3, aG[mt][nt], 0, 0, 0);
        }
      }
    }
    bfu* RW = (bfu*)(p.ws + (samp ? S_RW : P_RW)); bfu* G = (bfu*)(p.ws + (samp ? S_G : P_G)); float* BON = (float*)(p.ws + (samp ? S_BON : P_BON));
    float w0[4], a0[4], kkc[4], kac[4], rkc[4], mur[4], muk[4], muv[4];
    _Pragma("unroll") for (int nt = 0; nt < 4; ++nt) { const int c = h * 64 + nt * 16 + n16;
      w0[nt] = p.in[I_W0][layer * 384 + c]; a0[nt] = p.in[I_A0][layer * 384 + c]; kkc[nt] = p.in[I_KK][layer * 384 + c];
      kac[nt] = p.in[I_KA][layer * 384 + c]; rkc[nt] = p.in[I_RK][layer * 384 + c];
      mur[nt] = mu[c]; muk[nt] = mu[384 + c]; muv[nt] = mu[768 + c]; }
    _Pragma("unroll") for (int mt = 0; mt < 2; ++mt) _Pragma("unroll") for (int r = 0; r < 4; ++r) {
      const int tk = mt * 16 + kg * 4 + r;
      const bool usesh = (t0 + tk == 0);
      float rr[4], k2[4], kk[4], vv[4], dd[4], aa[4];
      float n2 = 0.f, bon = 0.f;
      _Pragma("unroll") for (int nt = 0; nt < 4; ++nt) {
        const int c = h * 64 + nt * 16 + n16;
        const bfu* qc = prt + (tk + 1) * 1152, *qp = prt + tk * 1152;
        const float cr = bf2f(qc[c]), ck = bf2f(qc[384 + c]), cv = bf2f(qc[768 + c]);
        const float pr_ = usesh ? (sh0 ? sh0[c] : 0.f) : bf2f(qp[c]);
        const float pk_ = usesh ? (sh0 ? sh0[384 + c] : 0.f) : bf2f(qp[384 + c]);
        const float pv_ = usesh ? (sh0 ? sh0[768 + c] : 0.f) : bf2f(qp[768 + c]);
        const float rv = cr + (pr_ - cr) * mur[nt], kv = ck + (pk_ - ck) * muk[nt]; vv[nt] = cv + (pv_ - cv) * muv[nt];
        const float z = -(w0[nt] + aW[mt][nt][r]);
        const float sp = fmaxf(z, 0.f) + __logf(1.f + __expf(-fabsf(z)));
        const float e = __expf(-sp - 0.5f);
        dd[nt] = 1.f - __expf(-e);
        const float a = sigmoidf_(a0[nt] + aA[mt][nt][r]);
        aa[nt] = a;
        const float kkr = kv * kkc[nt];
        kk[nt] = kkr; n2 += kkr * kkr;
        k2[nt] = kv * (1.f + (a - 1.f) * kac[nt]);
        rr[nt] = rv; bon += rv * k2[nt] * rkc[nt];
      }
      n2 = allred16(n2); bon = allred16(bon);
      const float inv = __builtin_amdgcn_rsqf(fmaxf(n2, 1e-24f));
      const long tok = (long)(b * 6 + h) * T + t0 + tk;
      bfu* o = RW + tok * 384;
      _Pragma("unroll") for (int nt = 0; nt < 4; ++nt) {
        const int j = nt * 16 + n16; const float kkn = kk[nt] * inv;
        o[j] = f2bf(dd[nt]); o[64 + j] = f2bf(k2[nt]); o[128 + j] = f2bf(kkn); o[192 + j] = f2bf(-kkn * aa[nt]); o[256 + j] = f2bf(rr[nt]); o[320 + j] = f2bf(vv[nt]);
        G[(long)(r0 + tk) * 384 + h * 64 + j] = f2bf(aG[mt][nt][r]);
      }
      if (n16 == 0) BON[(long)(r0 + tk) * 6 + h] = bon;
    }
  }
  __syncthreads();
}

constexpr int PSTR = 720;
constexpr int SCAN_DBUF = 16 * PSTR * 4;
struct ScanRegs { unsigned short a[4][12]; };
DI void scan_ld(ScanRegs& R, const bfu* RW, int chunk, int pg, int j) {
  _Pragma("unroll") for (int q = 0; q < 4; ++q) _Pragma("unroll") for (int sv = 0; sv < 12; ++sv)
    R.a[q][sv] = RW[((long)chunk * 32 + (pg * 4 + q) * 2 + sv / 6) * 384 + (sv % 6) * 64 + j];
}
DI void scan_derive(const ScanRegs& R, float* D, int pg, int j) {
  _Pragma("unroll") for (int q = 0; q < 4; ++q) {
    float* o = D + (pg * 4 + q) * PSTR;
    const float d1 = bf2f(R.a[q][0]), k1 = bf2f(R.a[q][1]), kk1 = bf2f(R.a[q][2]), ka1 = bf2f(R.a[q][3]), r1 = bf2f(R.a[q][4]), v1 = bf2f(R.a[q][5]);
    const float d2 = bf2f(R.a[q][6]), k2 = bf2f(R.a[q][7]), kk2 = bf2f(R.a[q][8]), ka2 = bf2f(R.a[q][9]), r2 = bf2f(R.a[q][10]), v2 = bf2f(R.a[q][11]);
    const float w1 = 1.f - d1, w2 = 1.f - d2, w12 = w1 * w2, ka1w2 = ka1 * w2, k1w2 = k1 * w2;
    o[j] = kk1; o[64 + j] = w1 * kk2; o[128 + j] = w1 * r1; o[192 + j] = w12 * r2; o[256 + j] = w12; o[320 + j] = ka1w2; o[384 + j] = k1w2;
    o[448 + j] = ka2; o[512 + j] = k2; o[576 + j] = v1; o[640 + j] = v2;
    const float c1 = wave_sum(ka1 * kk2), c2 = wave_sum(k1 * kk2), c3 = wave_sum(ka1 * r1), c4 = wave_sum(k1 * r1);
    const float c5 = wave_sum(ka1w2 * r2), c6 = wave_sum(k1w2 * r2), c7 = wave_sum(ka2 * r2), c8 = wave_sum(k2 * r2);
    if (j == 0) { *(float4*)(o + 704) = make_float4(c1, c2, c3, c4); *(float4*)(o + 708) = make_float4(c5, c6, c7, c8); }
  }
}
DI void scan_drain(const float* yb, bfu* Y, int chunk, int half, int ptid) {
  const int s = ptid >> 3, r4 = (ptid & 7) * 4;
  const float4 v = *(const float4*)(yb + s * 32 + r4);
  *(uint2*)(Y + (long)(chunk * 32 + s) * 384 + half * 32 + r4) = make_uint2(pack2(v.x, v.y), pack2(v.z, v.w));
}
typedef float f2 __attribute__((ext_vector_type(2)));
DI f2 lo2(const float4& a) { return f2{a.x, a.y}; }
DI f2 hi2(const float4& a) { return f2{a.z, a.w}; }
DI float dot4v(const f2 slo, const f2 shi, const float4& a) { const f2 t = slo * lo2(a) + shi * hi2(a); return t.x + t.y; }
DI void allred16x8(float& x0, float& x1, float& x2, float& x3, float& x4, float& x5, float& x6, float& x7) {
#define DPPSTAGE(N) \
  "v_add_f32_dpp %0, %0, %0 row_ror:" #N " row_mask:0xf bank_mask:0xf\n\t" \
  "v_add_f32_dpp %1, %1, %1 row_ror:" #N " row_mask:0xf bank_mask:0xf\n\t" \
  "v_add_f32_dpp %2, %2, %2 row_ror:" #N " row_mask:0xf bank_mask:0xf\n\t" \
  "v_add_f32_dpp %3, %3, %3 row_ror:" #N " row_mask:0xf bank_mask:0xf\n\t" \
  "v_add_f32_dpp %4, %4, %4 row_ror:" #N " row_mask:0xf bank_mask:0xf\n\t" \
  "v_add_f32_dpp %5, %5, %5 row_ror:" #N " row_mask:0xf bank_mask:0xf\n\t" \
  "v_add_f32_dpp %6, %6, %6 row_ror:" #N " row_mask:0xf bank_mask:0xf\n\t" \
  "v_add_f32_dpp %7, %7, %7 row_ror:" #N " row_mask:0xf bank_mask:0xf\n\t"
  asm volatile("s_nop 1\n\t" DPPSTAGE(8) DPPSTAGE(4) DPPSTAGE(2) DPPSTAGE(1)
               : "+v"(x0), "+v"(x1), "+v"(x2), "+v"(x3), "+v"(x4), "+v"(x5), "+v"(x6), "+v"(x7));
#undef DPPSTAGE
}
DI void rwkv_scan_unit(const Params& pin, int layer, int samp, int unit, char* shm) {
  const Params p = relaunder(pin);
  const int tid = ltid(p), wave = tid >> 6, lane = tid & 63, rg = lane >> 4, cgi = lane & 15;
  const int T = samp ? TS : SP; const int half = unit & 1, bh = unit >> 1; const int b = bh / 6, h = bh % 6;
  const bool act = wave < 4;
  const int ptid = tid & 255, pg = (wave & 3);
  const int lrow = (wave & 3) * 8 + rg * 2, row0 = half * 32 + lrow, col0 = cgi * 4;
  const bfu* RW = (const bfu*)(p.ws + (samp ? S_RW : P_RW)) + (long)bh * T * 384;
  bfu* Y = (bfu*)(p.ws + (samp ? S_Y : P_Y)) + (long)b * T * 384 + h * 64;
  float* ybuf = (float*)(shm + 2 * SCAN_DBUF);
  const int nch = T / 32;
  f2 Slo[2], Shi[2];
  ScanRegs R;
  if (act) {
    if (samp) { const float* s0 = p.in[I_SRW] + ((size_t)(layer * 16 + b) * 6 + h) * 4096;
      _Pragma("unroll") for (int rr = 0; rr < 2; ++rr) { float4 v = *(const float4*)(s0 + (row0 + rr) * 64 + col0); Slo[rr] = f2{v.x, v.y}; Shi[rr] = f2{v.z, v.w}; } }
    else { _Pragma("unroll") for (int rr = 0; rr < 2; ++rr) { Slo[rr] = f2{0.f, 0.f}; Shi[rr] = f2{0.f, 0.f}; } }
  } else {
    Slo[0] = Slo[1] = Shi[0] = Shi[1] = f2{0.f, 0.f};
    scan_ld(R, RW, 0, pg, lane); scan_derive(R, (float*)shm, pg, lane);
    if (1 < nch) scan_ld(R, RW, 1, pg, lane);
  }
  __syncthreads();
  for (int ch = 0; ch < nch; ++ch) {
    if (act) {
      const float* D = (const float*)(shm + (ch & 1) * SCAN_DBUF);
      float* yb = ybuf + (ch & 1) * 1024;
      for (int q = 0; q < 16; ++q) {
        const float* o = D + q * PSTR;
        const float4 kk1 = *(const float4*)(o + col0), w1k2 = *(const float4*)(o + 64 + col0), w1r1 = *(const float4*)(o + 128 + col0),
                     w12r2 = *(const float4*)(o + 192 + col0), w12 = *(const float4*)(o + 256 + col0), ka1w2 = *(const float4*)(o + 320 + col0),
                     k1w2 = *(const float4*)(o + 384 + col0), ka2 = *(const float4*)(o + 448 + col0), k2 = *(const float4*)(o + 512 + col0);
        const float2 v1 = *(const float2*)(o + 576 + row0), v2 = *(const float2*)(o + 640 + row0);
        const float4 ca = *(const float4*)(o + 704), cb = *(const float4*)(o + 708);
        float pa[2], pb[2], pc[2], pd[2];
        _Pragma("unroll") for (int rr = 0; rr < 2; ++rr) {
          pa[rr] = dot4v(Slo[rr], Shi[rr], kk1); pb[rr] = dot4v(Slo[rr], Shi[rr], w1k2);
          pc[rr] = dot4v(Slo[rr], Shi[rr], w1r1); pd[rr] = dot4v(Slo[rr], Shi[rr], w12r2); }
        allred16x8(pa[0], pa[1], pb[0], pb[1], pc[0], pc[1], pd[0], pd[1]);
        float y1[2], y2[2];
        _Pragma("unroll") for (int rr = 0; rr < 2; ++rr) {
          const float vv1 = rr ? v1.y : v1.x, vv2 = rr ? v2.y : v2.x;
          const float a1 = pa[rr];
          const float a2 = pb[rr] + a1 * ca.x + vv1 * ca.y;
          y1[rr] = pc[rr] + a1 * ca.z + vv1 * ca.w;
          y2[rr] = pd[rr] + a1 * cb.x + vv1 * cb.y + a2 * cb.z + vv2 * cb.w;
          Slo[rr] = Slo[rr] * lo2(w12) + a1 * lo2(ka1w2) + vv1 * lo2(k1w2) + a2 * lo2(ka2) + vv2 * lo2(k2);
          Shi[rr] = Shi[rr] * hi2(w12) + a1 * hi2(ka1w2) + vv1 * hi2(k1w2) + a2 * hi2(ka2) + vv2 * hi2(k2);
        }
        if (cgi == 0) { *(float2*)(yb + (2 * q) * 32 + lrow) = make_float2(y1[0], y1[1]); *(float2*)(yb + (2 * q + 1) * 32 + lrow) = make_float2(y2[0], y2[1]); }
      }
    } else {
      if (ch + 1 < nch) scan_derive(R, (float*)(shm + ((ch + 1) & 1) * SCAN_DBUF), pg, lane);
      if (ch + 2 < nch) scan_ld(R, RW, ch + 2, pg, lane);
      if (ch >= 1) scan_drain(ybuf + ((ch - 1) & 1) * 1024, Y, ch - 1, half, ptid);
    }
    __syncthreads();
  }
  if (!act) scan_drain(ybuf + ((nch - 1) & 1) * 1024, Y, nch - 1, half, ptid);
  if (act) {
    float* so = p.out + (samp ? O_RWS : O_RWP) + ((size_t)(layer * (samp ? 16 : 8) + b) * 6 + h) * 4096;
    _Pragma("unroll") for (int rr = 0; rr < 2; ++rr) *(float4*)(so + (row0 + rr) * 64 + col0) = make_float4(Slo[rr].x, Slo[rr].y, Shi[rr].x, Shi[rr].y);
  }
  __syncthreads();
}

constexpr size_t OFF_S5E = OFF_CTL + 65536;
constexpr int S5_NSEG = 8, S5_LSEG = SP / S5_NSEG;
DI void s5_unit(const Params& pin, int layer, int samp, int unit, int mode, char* shm) {
  const Params p = relaunder(pin);
  const int tid = ltid(p), wave = tid >> 6, lane = tid & 63;
  const int T = samp ? TS : SP;
  const int seg = samp ? 0 : (unit & 7); const int ub = samp ? unit : (unit >> 3);
  const int b = ub >> 1, g = (ub & 1) * 8 + wave;
  const int tbeg = samp ? 0 : seg * S5_LSEG, tend = samp ? TS : tbeg + S5_LSEG;
  float2* Eb = (float2*)(p.ws + OFF_S5E) + ((size_t)(b * 16 + g) * S5_NSEG) * 64 + lane;
  const int gp = (layer * 16 + g) * 64 + lane;
  const float lre = p.in[I_LRE][gp], lim = p.in[I_LIM][gp];
  const float dt = expf(p.in[I_LDT][layer * 16 + g]);
  const float ang = lim * dt;
  const float sn = sinf(ang), cs = cosf(ang);
  const float mag = expf(lre * dt);
  const float lr = mag * cs, li = mag * sn;
  const float nr = lr - 1.f, ni = li, den = lre * lre + lim * lim;
  const float cr_ = (nr * lre + ni * lim) / den, ci_ = (ni * lre - nr * lim) / den;
  float Br[16], Bi[16];
  { const float* bre = p.in[I_BRE] + (size_t)gp * 16, *bim = p.in[I_BIM] + (size_t)gp * 16;
    _Pragma("unroll") for (int c = 0; c < 16; ++c) { const float br = bre[c], bi = bim[c]; Br[c] = cr_ * br - ci_ * bi; Bi[c] = cr_ * bi + ci_ * br; } }
  bf16x8 Cf[4];
  { const int n = lane & 15, kg = lane >> 4;
    const float* cre = p.in[I_CRE] + ((size_t)(layer * 16 + g) * 16 + n) * 64, *cim = p.in[I_CIM] + ((size_t)(layer * 16 + g) * 16 + n) * 64;
    _Pragma("unroll") for (int s = 0; s < 4; ++s) _Pragma("unroll") for (int j = 0; j < 8; ++j) { int k = 32 * s + 8 * kg + j;
      float v = (k < 64) ? cre[k] : -cim[k - 64]; Cf[s][j] = (short)f2bf(v); } }
  const float Dd = p.in[I_S5D][layer * 256 + g * 16 + (lane & 15)];
  float xr = 0.f, xi = 0.f;
  if (samp) { const float* s0 = p.in[I_SS5] + ((size_t)(layer * 16 + b) * 16 + g) * 128 + lane * 2; xr = s0[0]; xi = s0[1]; }
  else if (mode == 2 && seg > 0) {
    const float magL = expf((float)S5_LSEG * lre * dt);
    const float angr = ang - 6.283185307179586f * rintf(ang * 0.15915494309189535f);
    const float angL = (float)S5_LSEG * angr;
    const float Lr = magL * cosf(angL), Li = magL * sinf(angL);
    for (int s2 = 0; s2 < seg; ++s2) { const float2 ev = Eb[s2 * 64];
      const float nr_ = Lr * xr - Li * xi + ev.x, ni_ = Lr * xi + Li * xr + ev.y; xr = nr_; xi = ni_; }
  }
  char* wsm = shm + wave * 6144;
  float* ut = (float*)wsm; bfu* xt = (bfu*)(wsm + 1024);
  const bfu* U = (const bfu*)(p.ws + (samp ? S_U : P_U)) + (long)b * T * 256 + g * 16;
  bfu* ZO = (bfu*)(p.ws + (samp ? S_ZS5 : P_ZS5)) + (long)b * T * 256 + g * 16;
  uint4 un = make_uint4(0, 0, 0, 0);
  if (lane < 32) un = *(const uint4*)(U + (long)(tbeg + (lane >> 1)) * 256 + (lane & 1) * 8);
  for (int t0 = tbeg; t0 < tend; t0 += 16) {
    if (lane < 32) { const unsigned w[4] = {un.x, un.y, un.z, un.w}; float* d = ut + (lane >> 1) * 16 + (lane & 1) * 8;
      *(float4*)d = make_float4(bf2f(w[0] & 0xffff), bf2f(w[0] >> 16), bf2f(w[1] & 0xffff), bf2f(w[1] >> 16));
      *(float4*)(d + 4) = make_float4(bf2f(w[2] & 0xffff), bf2f(w[2] >> 16), bf2f(w[3] & 0xffff), bf2f(w[3] >> 16)); }
    if (t0 + 16 < tend && lane < 32) un = *(const uint4*)(U + (long)(t0 + 16 + (lane >> 1)) * 256 + (lane & 1) * 8);
    __builtin_amdgcn_fence(__ATOMIC_RELEASE, "wavefront"); __builtin_amdgcn_wave_barrier(); __builtin_amdgcn_fence(__ATOMIC_ACQUIRE, "wavefront");
    for (int tt = 0; tt < 16; ++tt) {
      const float4* up = (const float4*)(ut + tt * 16);
      const float4 u0 = up[0], u1 = up[1], u2 = up[2], u3 = up[3];
      const float u[16] = {u0.x, u0.y, u0.z, u0.w, u1.x, u1.y, u1.z, u1.w, u2.x, u2.y, u2.z, u2.w, u3.x, u3.y, u3.z, u3.w};
      float br = 0.f, bi = 0.f;
      _Pragma("unroll") for (int c = 0; c < 16; ++c) { br += Br[c] * u[c]; bi += Bi[c] * u[c]; }
      const float nxr = lr * xr - li * xi + br, nxi = lr * xi + li * xr + bi;
      xr = nxr; xi = nxi;
      if (mode == 2) { xt[tt * 136 + lane] = f2bf(xr); xt[tt * 136 + 64 + lane] = f2bf(xi); }
    }
    if (mode == 2) {
    __builtin_amdgcn_fence(__ATOMIC_RELEASE, "wavefront"); __builtin_amdgcn_wave_barrier(); __builtin_amdgcn_fence(__ATOMIC_ACQUIRE, "wavefront");
    f32x4 acc = {0.f, 0.f, 0.f, 0.f};
    { const int row = lane & 15, kg = lane >> 4;
      _Pragma("unroll") for (int s = 0; s < 4; ++s) { bf16x8 a = *(const bf16x8*)(xt + row * 136 + 32 * s + 8 * kg);
        acc = __builtin_amdgcn_mfma_f32_16x16x32_bf16(a, Cf[s], acc, 0, 0, 0); } }
    { const int ch = lane & 15, tq = lane >> 4;
      _Pragma("unroll") for (int r = 0; r < 4; ++r) { const int tk = tq * 4 + r;
        float y = acc[r] + Dd * ut[tk * 16 + ch];
        float z = 0.5f * y * (1.f + tanhf_(0.7978845608028654f * (y + 0.044715f * y * y * y)));
        ZO[(long)(t0 + tk) * 256 + ch] = f2bf(z); } }
    }
    __builtin_amdgcn_fence(__ATOMIC_RELEASE, "wavefront"); __builtin_amdgcn_wave_barrier(); __builtin_amdgcn_fence(__ATOMIC_ACQUIRE, "wavefront");
  }
  if (mode == 1) { Eb[seg * 64] = make_float2(xr, xi); }
  else if (samp || seg == S5_NSEG - 1) {
    float* so = p.out + (samp ? O_S5S : O_S5P) + ((size_t)(layer * (samp ? 16 : 8) + b) * 16 + g) * 128 + lane * 2;
    so[0] = xr; so[1] = xi; }
}

template <int DQK, int DV>
struct Attn {
  static constexpr int PK = DQK * 2 + 16, PV = 144;
  static constexpr int KT_BYTES = 64 * PK, VT_BYTES = DV * PV, BUF = KT_BYTES + VT_BYTES;
  static constexpr int NCK = 64 * DQK / 8, NCV = DV * 8, NC = NCK + NCV, NLD = (NC + NT - 1) / NT;
  static_assert(NLD <= 5, "NLD");
  static constexpr int NS = DQK / 16, NMT = DV / 32;
  static_assert(2 * BUF + 49152 <= SHM_MAIN, "attn LDS");


  struct St { uint4 a0, a1, a2, a3, a4; };
  template <int I> static DI void g1(uint4& s, const bfu* Kbase, const bfu* Vtbase, long Tstride, int tile, const int tid) {
    if constexpr (I < NLD) { const int c = tid + I * NT;
      if (c < NCK) s = *(const uint4*)(Kbase + (long)tile * 64 * DQK + (long)c * 8);
      else if (c < NC) { const int cv = c - NCK, d = cv >> 3, part = cv & 7; s = *(const uint4*)(Vtbase + (long)d * Tstride + (long)tile * 64 + part * 8); } }
  }
  template <int I> static DI void s1(const uint4& s, char* base, const int tid) {
    if constexpr (I < NLD) { const int c = tid + I * NT;
      if (c < NCK) { const int row = c / (DQK / 8), col = c % (DQK / 8); *(uint4*)(base + row * PK + col * 16) = s; }
      else if (c < NC) { const int cv = c - NCK, d = cv >> 3, part = cv & 7; *(uint4*)(base + KT_BYTES + d * PV + part * 16) = s; } }
  }
  static DI void gload(St& st, const bfu* Kbase, const bfu* Vtbase, long Tstride, int tile, const int tid) {
    g1<0>(st.a0, Kbase, Vtbase, Tstride, tile, tid); g1<1>(st.a1, Kbase, Vtbase, Tstride, tile, tid); g1<2>(st.a2, Kbase, Vtbase, Tstride, tile, tid);
    g1<3>(st.a3, Kbase, Vtbase, Tstride, tile, tid); g1<4>(st.a4, Kbase, Vtbase, Tstride, tile, tid);
  }
  static DI void lstore(const St& st, char* shm, int buf, const int tid) {
    char* base = shm + buf * BUF;
    s1<0>(st.a0, base, tid); s1<1>(st.a1, base, tid); s1<2>(st.a2, base, tid); s1<3>(st.a3, base, tid); s1<4>(st.a4, base, tid);
  }
  static DI float xmax32(float x) {
    const unsigned u = __float_as_uint(x);
    auto r = __builtin_amdgcn_permlane32_swap(u, u, false, false);
    return fmaxf(__uint_as_float(r[0]), __uint_as_float(r[1]));
  }
  static DI float xsum32(float x) {
    const unsigned u = __float_as_uint(x);
    auto r = __builtin_amdgcn_permlane32_swap(u, u, false, false);
    return __uint_as_float(r[0]) + __uint_as_float(r[1]);
  }
  static DI float softmax32(f32x16& s, const int keybase, const int key_limit, const bool domask, const bool force, f32x16 (&O)[NMT], f32x16& negm,
                           float& mrun, float& l, const int hh, bf16x8 (&pf)[2]) {
    if (domask) { _Pragma("unroll") for (int r = 0; r < 16; ++r) { const int key = keybase + crow(r, hh); if (key >= key_limit) s[r] = -1e30f; } }
    float mx = fmaxf(s[0], s[1]);
    _Pragma("unroll") for (int r = 2; r < 16; ++r) mx = fmaxf(mx, s[r]);
    mx = xmax32(mx);
    float shift = 0.f;
    if (mx > 6.f || force) {
      shift = mx;
      mrun += mx;
      if (!force) {
        const float corr = __builtin_amdgcn_exp2f(-mx);
        l *= corr;
        _Pragma("unroll") for (int mt = 0; mt < NMT; ++mt) _Pragma("unroll") for (int r = 0; r < 16; ++r) O[mt][r] *= corr;
      }
      _Pragma("unroll") for (int r = 0; r < 16; ++r) { s[r] -= mx; negm[r] = -mrun; }
    }
    _Pragma("unroll") for (int r = 0; r < 16; ++r) { const float pv = __builtin_amdgcn_exp2f(s[r]); l += pv; s[r] = pv; }
    _Pragma("unroll") for (int sp = 0; sp < 2; ++sp) _Pragma("unroll") for (int j = 0; j < 8; ++j) pf[sp][j] = (short)f2bf(s[8 * sp + j]);
    return shift;
  }
  static DI void pv32(const char* vb, const int k2, const bf16x8 (&pf)[2], f32x16 (&O)[NMT], const int ln, const int hh) {
    _Pragma("unroll") for (int sp = 0; sp < 2; ++sp) _Pragma("unroll") for (int mt = 0; mt < NMT; ++mt) {
      const char* vp = vb + (mt * 32 + ln) * PV + (k2 * 32 + sp * 16 + hh * 4) * 2;
      s16x4 lo = *(const s16x4*)vp, hi = *(const s16x4*)(vp + 16);
      bf16x8 vf = __builtin_shufflevector(lo, hi, 0, 1, 2, 3, 4, 5, 6, 7);
      O[mt] = __builtin_amdgcn_mfma_f32_32x32x16_bf16(vf, pf[sp], O[mt], 0, 0, 0);
    }
  }
  static DI void compute(const char* kb, const int kt, const int key_limit, const bf16x8 (&qf)[NS], f32x16 (&O)[NMT], f32x16& negm,
                         float& mrun, float& l, const int ln, const int hh) {
    const char* vb = kb + KT_BYTES;
    f32x16 s0 = negm, s1 = negm;
    _Pragma("unroll") for (int si = 0; si < NS; ++si) {
      bf16x8 a = *(const bf16x8*)(kb + ln * PK + (si * 16 + hh * 8) * 2);
      s0 = __builtin_amdgcn_mfma_f32_32x32x16_bf16(a, qf[si], s0, 0, 0, 0);
    }
    _Pragma("unroll") for (int si = 0; si < NS; ++si) {
      bf16x8 a = *(const bf16x8*)(kb + (32 + ln) * PK + (si * 16 + hh * 8) * 2);
      s1 = __builtin_amdgcn_mfma_f32_32x32x16_bf16(a, qf[si], s1, 0, 0, 0);
    }
    __builtin_amdgcn_sched_barrier(0);
    const bool domask = (kt + 1) * 64 > key_limit;
    bf16x8 pf[2];
    const float sh0 = softmax32(s0, kt * 64, key_limit, domask, kt == 0, O, negm, mrun, l, hh, pf);
    __builtin_amdgcn_sched_barrier(0);
    pv32(vb, 0, pf, O, ln, hh);
    __builtin_amdgcn_sched_barrier(0);
    bf16x8 pg[2];
    if (sh0 != 0.f) { _Pragma("unroll") for (int r = 0; r < 16; ++r) s1[r] -= sh0; }
    softmax32(s1, kt * 64 + 32, key_limit, domask, false, O, negm, mrun, l, hh, pg);
    __builtin_amdgcn_sched_barrier(0);
    pv32(vb, 1, pg, O, ln, hh);
  }

  static DI void run(const bfu* Kbase, const bfu* Vtbase, long Tstride, int ntiles_unit, int my_ntiles, int key_limit,
                     const bfu* qptr  , char* shm, f32x16 (&O)[NMT], float& lsum, const int tid) {
    const int lane = tid & 63, ln = lane & 31, hh = lane >> 5;
    bf16x8 qf[NS];
    if (my_ntiles > 0) { _Pragma("unroll") for (int s = 0; s < NS; ++s) qf[s] = *(const bf16x8*)(qptr + s * 16 + hh * 8); }
    else { _Pragma("unroll") for (int s = 0; s < NS; ++s) qf[s] = bf16x8{0, 0, 0, 0, 0, 0, 0, 0}; }
    _Pragma("unroll") for (int mt = 0; mt < NMT; ++mt) _Pragma("unroll") for (int r = 0; r < 16; ++r) O[mt][r] = 0.f;
    float mrun = 0.f, l = 0.f;
    f32x16 negm; _Pragma("unroll") for (int r = 0; r < 16; ++r) negm[r] = 0.f;
    St s0, s1;
    s0.a0 = s0.a1 = s0.a2 = s0.a3 = s0.a4 = make_uint4(0, 0, 0, 0); s1 = s0;
    const int n = ntiles_unit;
    gload(s0, Kbase, Vtbase, Tstride, 0, tid); lstore(s0, shm, 0, tid);
    if (1 < n) gload(s0, Kbase, Vtbase, Tstride, 1, tid);
    __syncthreads();
    for (int kt = 0; kt < n; kt += 2) {
      if (kt + 2 < n) gload(s1, Kbase, Vtbase, Tstride, kt + 2, tid);
      if (kt < my_ntiles) compute(shm, kt, key_limit, qf, O, negm, mrun, l, ln, hh);
      if (kt + 1 < n) lstore(s0, shm, 1, tid);
      __syncthreads();
      if (kt + 1 < n) {
        if (kt + 3 < n) gload(s0, Kbase, Vtbase, Tstride, kt + 3, tid);
        if (kt + 1 < my_ntiles) compute(shm + BUF, kt + 1, key_limit, qf, O, negm, mrun, l, ln, hh);
        if (kt + 2 < n) lstore(s1, shm, 0, tid);
        __syncthreads();
      }
    }
    lsum = xsum32(l);
  }
};


struct AttnP {
  static constexpr int DQK = 96, DV = 64;
  static constexpr int PK = DQK * 2 + 16, PV = 144;
  static constexpr int KT_BYTES = 64 * PK, VT_BYTES = DV * PV, BUF = KT_BYTES + VT_BYTES;
  static constexpr int NCK = 64 * DQK / 8, NCV = DV * 8, NC = NCK + NCV;
  static constexpr int NS = DQK / 16, NMT = DV / 32;
  struct St { uint4 a0, a1, a2; };
  template <int I> static DI void g1(uint4& s, const bfu* Kbase, const bfu* Vtbase, long Tstride, int tile, const int tid) {
    const int c = tid + I * NT;
    if (c < NCK) s = *(const uint4*)(Kbase + (long)tile * 64 * DQK + (long)c * 8);
    else if (c < NC) { const int cv = c - NCK, d = cv >> 3, part = cv & 7; s = *(const uint4*)(Vtbase + (long)d * Tstride + (long)tile * 64 + part * 8); }
  }
  template <int I> static DI void s1(const uint4& s, char* base, const int tid) {
    const int c = tid + I * NT;
    if (c < NCK) { const int row = c / (DQK / 8), col = c % (DQK / 8); *(uint4*)(base + row * PK + col * 16) = s; }
    else if (c < NC) { const int cv = c - NCK, d = cv >> 3, part = cv & 7; const int g = part >> 1, a = part & 1;
      char* row = base + KT_BYTES + d * PV + g * 32;
      *(uint2*)(row + 8 * a) = make_uint2(s.x, s.y); *(uint2*)(row + 16 + 8 * a) = make_uint2(s.z, s.w); }
  }
  static DI void gload(St& st, const bfu* Kbase, const bfu* Vtbase, long Tstride, int tile, const int tid) {
    g1<0>(st.a0, Kbase, Vtbase, Tstride, tile, tid); g1<1>(st.a1, Kbase, Vtbase, Tstride, tile, tid); g1<2>(st.a2, Kbase, Vtbase, Tstride, tile, tid);
  }
  static DI void lstore(const St& st, char* base, const int tid) { s1<0>(st.a0, base, tid); s1<1>(st.a1, base, tid); s1<2>(st.a2, base, tid); }
  static DI float xmax32(float x) { const unsigned u = __float_as_uint(x); auto r = __builtin_amdgcn_permlane32_swap(u, u, false, false);
    return fmaxf(__uint_as_float(r[0]), __uint_as_float(r[1])); }
  static DI float xsum32(float x) { const unsigned u = __float_as_uint(x); auto r = __builtin_amdgcn_permlane32_swap(u, u, false, false);
    return __uint_as_float(r[0]) + __uint_as_float(r[1]); }
  static DI void softmax32(f32x16& s, const bool force, f32x16 (&O)[NMT], float& mrun, float& l) {
    float mx = fmaxf(s[0], s[1]);
    _Pragma("unroll") for (int r = 2; r < 16; ++r) mx = fmaxf(mx, s[r]);
    mx = xmax32(mx);
    if (mx > mrun + 6.f || force) {
      if (!force) { const float corr = __builtin_amdgcn_exp2f(mrun - mx); l *= corr;
        _Pragma("unroll") for (int mt = 0; mt < NMT; ++mt) _Pragma("unroll") for (int r = 0; r < 16; ++r) O[mt][r] *= corr; }
      mrun = mx;
    }
    const float m = mrun;
    _Pragma("unroll") for (int r = 0; r < 16; ++r) { const float pv = __builtin_amdgcn_exp2f(s[r] - m); l += pv; s[r] = pv; }
  }
  static DI void compute(const char* kb, const bool first, const bf16x8 (&qa)[NS], const bf16x8 (&qb)[NS], f32x16 (&OA)[NMT], f32x16 (&OB)[NMT],
                         float& mA, float& mB, float& lA, float& lB, const int ln, const int hh) {
    const char* vb = kb + KT_BYTES;
    _Pragma("unroll") for (int k2 = 0; k2 < 2; ++k2) {
      f32x16 sA, sB;
      _Pragma("unroll") for (int r = 0; r < 16; ++r) { sA[r] = 0.f; sB[r] = 0.f; }
      _Pragma("unroll") for (int si = 0; si < NS; ++si) {
        const bf16x8 a = *(const bf16x8*)(kb + (k2 * 32 + ln) * PK + (si * 16 + hh * 8) * 2);
        sA = __builtin_amdgcn_mfma_f32_32x32x16_bf16(a, qa[si], sA, 0, 0, 0);
        sB = __builtin_amdgcn_mfma_f32_32x32x16_bf16(a, qb[si], sB, 0, 0, 0);
      }
      softmax32(sA, first && k2 == 0, OA, mA, lA);
      softmax32(sB, first && k2 == 0, OB, mB, lB);
      _Pragma("unroll") for (int sp = 0; sp < 2; ++sp) {
        bf16x8 pA, pB;
        _Pragma("unroll") for (int j = 0; j < 8; ++j) { pA[j] = (short)f2bf(sA[8 * sp + j]); pB[j] = (short)f2bf(sB[8 * sp + j]); }
        _Pragma("unroll") for (int mt = 0; mt < NMT; ++mt) {
          const bf16x8 vf = *(const bf16x8*)(vb + (mt * 32 + ln) * PV + (k2 * 32 + sp * 16) * 2 + hh * 16);
          OA[mt] = __builtin_amdgcn_mfma_f32_32x32x16_bf16(vf, pA, OA[mt], 0, 0, 0);
          OB[mt] = __builtin_amdgcn_mfma_f32_32x32x16_bf16(vf, pB, OB[mt], 0, 0, 0);
        }
      }
    }
  }
  static DI void run(const bfu* Kbase, const bfu* Vtbase, long Tstride, int ntiles_unit, int my_ntiles, const bfu* qptr, long qstride,
                     char* shm, f32x16 (&OA)[NMT], f32x16 (&OB)[NMT], float& lsA, float& lsB, const int tid) {
    const int lane = tid & 63, ln = lane & 31, hh = lane >> 5;
    bf16x8 qa[NS], qb[NS];
    _Pragma("unroll") for (int s = 0; s < NS; ++s) { qa[s] = *(const bf16x8*)(qptr + s * 16 + hh * 8); qb[s] = *(const bf16x8*)(qptr + 32 * qstride + s * 16 + hh * 8); }
    _Pragma("unroll") for (int mt = 0; mt < NMT; ++mt) _Pragma("unroll") for (int r = 0; r < 16; ++r) { OA[mt][r] = 0.f; OB[mt][r] = 0.f; }
    float mA = 0.f, mB = 0.f, lA = 0.f, lB = 0.f;
    St st; st.a0 = st.a1 = st.a2 = make_uint4(0, 0, 0, 0);
    const int n = ntiles_unit;
    gload(st, Kbase, Vtbase, Tstride, 0, tid); lstore(st, shm, tid);
    if (1 < n) gload(st, Kbase, Vtbase, Tstride, 1, tid);
    __syncthreads();
    for (int kt = 0; kt < n; ++kt) {
      if (kt < my_ntiles) compute(shm + (kt & 1) * BUF, kt == 0, qa, qb, OA, OB, mA, mB, lA, lB, ln, hh);
      if (kt + 1 < n) lstore(st, shm + ((kt + 1) & 1) * BUF, tid);
      if (kt + 2 < n) gload(st, Kbase, Vtbase, Tstride, kt + 2, tid);
      __syncthreads();
    }
    lsA = xsum32(lA); lsB = xsum32(lB);
  }
};

DI void attn_prompt_unit(const Params& pin, const int bh, const int qb, char* shm) {
  const Params p = relaunder(pin);
  const int b = bh / 6, h = bh % 6;
  const int tidu = ltid(p);
  const int wave = tidu >> 6, lane = tidu & 63, ln = lane & 31, hh = lane >> 5;
  const int q0 = qb * 512 + wave * 64;
  const bfu* Kb = (const bfu*)(p.ws + P_KB) + (long)bh * SP * 96;
  const bfu* Vt = (const bfu*)(p.ws + P_VT) + (long)bh * 64 * SP;
  const bfu* Q = (const bfu*)(p.ws + P_Q) + ((long)b * SP + q0 + ln) * 576 + h * 96;
  f32x16 OA[2], OB[2]; float lsA, lsB;
  AttnP::run(Kb, Vt, SP, qb * 8 + 8, q0 / 64 + 1, Q, 576, shm, OA, OB, lsA, lsB, tidu);
  const float invA = 1.f / lsA, invB = 1.f / lsB;
  bfu* MG = (bfu*)(p.ws + P_MERGED) + ((long)b * SP + q0 + ln) * 1024 + h * 64;
  _Pragma("unroll") for (int mt = 0; mt < 2; ++mt) _Pragma("unroll") for (int g = 0; g < 4; ++g) {
    const int d0 = mt * 32 + 8 * g + 4 * hh;
    *(uint2*)(MG + d0) = make_uint2(pack2(OA[mt][4 * g] * invA, OA[mt][4 * g + 1] * invA), pack2(OA[mt][4 * g + 2] * invA, OA[mt][4 * g + 3] * invA));
    *(uint2*)(MG + 32 * 1024 + d0) = make_uint2(pack2(OB[mt][4 * g] * invB, OB[mt][4 * g + 1] * invB), pack2(OB[mt][4 * g + 2] * invB, OB[mt][4 * g + 3] * invB));
  }
}

DI void attn_sample_unit(const Params& pin, int layer, int b, char* shm) {
  const Params p = relaunder(pin);
  const int tid = ltid(p), wave = tid >> 6, lane = tid & 63, ln = lane & 31, hh = lane >> 5;
  const bfu* Qs = (const bfu*)(p.ws + S_Q);
  bfu* QA = (bfu*)(p.ws + S_QABS);
  const float* WK = p.in[I_WKVB] + (size_t)layer * 128 * 768;
  for (int it = tid; it < 768; it += NT) {
    const int h = it >> 7, c = it & 127;
    float wcol[64];
    _Pragma("unroll") for (int d = 0; d < 64; d += 4) { float4 v = *(const float4*)(WK + c * 768 + h * 128 + d); wcol[d] = v.x; wcol[d + 1] = v.y; wcol[d + 2] = v.z; wcol[d + 3] = v.w; }
    for (int row = 0; row < 32; ++row) {
      const bfu* q = Qs + (long)(b * 32 + row) * 576 + h * 96;
      float acc = 0.f;
      _Pragma("unroll") for (int d = 0; d < 64; ++d) acc += bf2f(q[d]) * wcol[d];
      QA[((long)(b * 6 + h) * 32 + row) * 160 + c] = f2bf(acc);
    }
  }
  for (int e = tid; e < 6 * 32 * 32; e += NT) { const int h = e >> 10, row = (e >> 5) & 31, c = e & 31;
    QA[((long)(b * 6 + h) * 32 + row) * 160 + 128 + c] = Qs[(long)(b * 32 + row) * 576 + h * 96 + 64 + c]; }
  __threadfence(); __syncthreads();
  const bfu* Kc = (const bfu*)(p.ws + S_KCAT) + (long)b * SKP * 160;
  const bfu* Vt = (const bfu*)(p.ws + S_VT) + (long)b * 128 * SKP;
  const int hw = wave < 6 ? wave : 0;
  const bfu* Q = QA + ((long)(b * 6 + hw) * 32 + ln) * 160;
  bfu* stash = (bfu*)(shm + 2 * Attn<160, 64>::BUF);
  for (int half = 0; half < 2; ++half) {
    f32x16 O[2]; float lsum;
    Attn<160, 64>::run(Kc, Vt + (long)half * 64 * SKP, SKP, 65, wave < 6 ? 65 : 0, SKS, Q, shm, O, lsum, tid);
    if (wave < 6) { const float inv = 1.f / lsum;
      _Pragma("unroll") for (int mt = 0; mt < 2; ++mt) _Pragma("unroll") for (int r = 0; r < 16; ++r)
        stash[half * 12288 + (wave * 32 + ln) * 64 + mt * 32 + crow(r, hh)] = f2bf(O[mt][r] * inv); }
    __syncthreads();
  }
  if (wave < 6) {
    const int h = wave, c = lane;
    float acc[32];
    _Pragma("unroll") for (int r = 0; r < 32; ++r) acc[r] = 0.f;
    for (int d = 0; d < 128; ++d) { const float w = WK[d * 768 + h * 128 + 64 + c];
      const bfu* o = stash + (d >> 6) * 12288 + h * 32 * 64 + (d & 63);
      _Pragma("unroll") for (int r = 0; r < 32; ++r) acc[r] += bf2f(o[r * 64]) * w; }
    bfu* MG = (bfu*)(p.ws + S_MERGED);
    _Pragma("unroll") for (int r = 0; r < 32; ++r) MG[(long)(b * 32 + r) * 1024 + h * 64 + c] = f2bf(acc[r]);
  }
  __syncthreads();
}

DI void rwkv_post(const Params& pin, int layer) {
  const Params p = relaunder(pin);
  const int tidw = ltid(p); const int wave = tidw >> 6, lane = tidw & 63, sub = lane >> 4, l16 = lane & 15;
  const long total = (long)(MP + MS) * 6;
  const float* gng = p.in[I_GNG] + layer * 384; const float* gnb = p.in[I_GNB] + layer * 384;
  for (long u0 = ((long)blockIdx.x * 8 + wave) * 16; u0 < total; u0 += (long)gridDim.x * 8 * 16) {
    uint2 yv[4], vv[4], gv[4]; float bon[4]; long mgo[4]; int cc[4]; int sm[4];
    _Pragma("unroll") for (int i = 0; i < 4; ++i) {
      const long u = u0 + i * 4 + sub;
      const int samp = u >= (long)MP * 6; const long uu = samp ? u - (long)MP * 6 : u;
      const long r = uu / 6; const int h = (int)(uu - r * 6); const int LT = samp ? 5 : 13; const int T = 1 << LT;
      const long b = r >> LT, t = r & (T - 1); const int c = h * 64 + l16 * 4;
      const bfu* Y = (const bfu*)(p.ws + (samp ? S_Y : P_Y)); const bfu* G = (const bfu*)(p.ws + (samp ? S_G : P_G));
      const float* BON = (const float*)(p.ws + (samp ? S_BON : P_BON)); const bfu* RW = (const bfu*)(p.ws + (samp ? S_RW : P_RW));
      yv[i] = *(const uint2*)(Y + r * 384 + c);
      vv[i] = *(const uint2*)(RW + ((b * 6 + h) * T + t) * 384 + 320 + l16 * 4);
      gv[i] = *(const uint2*)(G + r * 384 + c); bon[i] = BON[r * 6 + h];
      mgo[i] = r * 1024 + 640 + c; cc[i] = c; sm[i] = samp;
    }
    _Pragma("unroll") for (int i = 0; i < 4; ++i) {
      const float y0 = bf2f(yv[i].x & 0xffff), y1 = bf2f(yv[i].x >> 16), y2 = bf2f(yv[i].y & 0xffff), y3 = bf2f(yv[i].y >> 16);
      const float mu = allred16(y0 + y1 + y2 + y3) * (1.f / 64);
      const float d0 = y0 - mu, d1 = y1 - mu, d2 = y2 - mu, d3 = y3 - mu;
      const float var = allred16(d0 * d0 + d1 * d1 + d2 * d2 + d3 * d3) * (1.f / 64);
      const float rs = rsqrtf(var + 64e-5f);
      const float4 g4 = *(const float4*)(gng + cc[i]), b4 = *(const float4*)(gnb + cc[i]);
      const float v0 = bf2f(vv[i].x & 0xffff), v1 = bf2f(vv[i].x >> 16), v2 = bf2f(vv[i].y & 0xffff), v3 = bf2f(vv[i].y >> 16);
      const float q0 = bf2f(gv[i].x & 0xffff), q1 = bf2f(gv[i].x >> 16), q2 = bf2f(gv[i].y & 0xffff), q3 = bf2f(gv[i].y >> 16);
      const float o0 = (d0 * rs * g4.x + b4.x + bon[i] * v0) * q0, o1 = (d1 * rs * g4.y + b4.y + bon[i] * v1) * q1;
      const float o2 = (d2 * rs * g4.z + b4.z + bon[i] * v2) * q2, o3 = (d3 * rs * g4.w + b4.w + bon[i] * v3) * q3;
      bfu* MG = (bfu*)(p.ws + (sm[i] ? S_MERGED : P_MERGED));
      *(uint2*)(MG + mgo[i]) = make_uint2(pack2(o0, o1), pack2(o2, o3));
    }
  }
}


#define XB_TMO      128
#define XB_XCNT(j)  (256  + 64 * (j))
#define XB_XSUB(j)  (1280 + 64 * (j))
#define XB_XGEN(j)  (2304 + 64 * (j))
#define XB_TOP      3328
#define XB_TOPGEN   3392
#define XCD_BAR_WORDS 3456
#define XB_SPIN_CAP (1u << 18)
#define LAS __attribute__((address_space(3)))
constexpr size_t OFF_BAR = OFF_CTL + 655360;
DI unsigned xb_ld(unsigned* p) { return __hip_atomic_load(p, __ATOMIC_RELAXED, __HIP_MEMORY_SCOPE_AGENT); }
DI unsigned xb_add(unsigned* p, unsigned v) { return __hip_atomic_fetch_add(p, v, __ATOMIC_RELAXED, __HIP_MEMORY_SCOPE_AGENT); }
DI unsigned xb_xcc_id() { return (unsigned)__builtin_amdgcn_s_getreg((3 << 11) | 20) & 0xFu; }
#define XB_SPIN(cond, bar) do { unsigned _sp = 0; while (cond) { __builtin_amdgcn_s_sleep(1); \
    if ((++_sp & 255u) == 0u) { if (xb_ld(&(bar)[XB_TMO])) break; if (_sp > XB_SPIN_CAP) { atomicAdd(&(bar)[XB_TMO], 1u); break; } } } } while (0)
DI void xcd_barrier_complete(unsigned* bar, unsigned x, unsigned& nloc, unsigned& nx) {
  const unsigned G = gridDim.x;
  unsigned sum, cnt, mine, sp = 0u;
  for (;;) {
    sum = 0u; cnt = 0u; mine = 0u;
    _Pragma("unroll") for (unsigned j = 0; j < 16; ++j) { const unsigned c = xb_ld(&bar[XB_XCNT(j)]); sum += c; cnt += (c > 0u) ? 1u : 0u; mine = (j == x) ? c : mine; }
    if (sum == G) break;
    __builtin_amdgcn_s_sleep(1);
    if ((++sp & 255u) == 0u) { if (xb_ld(&bar[XB_TMO])) break; if (sp > XB_SPIN_CAP) { atomicAdd(&bar[XB_TMO], 1u); break; } }
  }
  nloc = mine > 0u ? mine : 1u; nx = cnt > 0u ? cnt : 1u;
}
DI void xcd_barrier(unsigned* bar, const unsigned x, char* shm, const bool leader) {
  volatile LAS unsigned* st = (volatile LAS unsigned*)(shm + SHM_MAIN + 1040);
  asm volatile("s_waitcnt vmcnt(0)" ::: "memory");
  __syncthreads();
  if (leader) {
    __builtin_amdgcn_s_waitcnt(0);
    unsigned nloc = st[0], nx = st[1];
    if (nloc == 0u) { xcd_barrier_complete(bar, x, nloc, nx); st[0] = nloc; st[1] = nx; }
    const unsigned old = xb_add(&bar[XB_XSUB(x)], 1u);
    const unsigned gen = old / nloc;
    if (old + 1u == (gen + 1u) * nloc) {
      __builtin_amdgcn_fence(__ATOMIC_RELEASE, "agent");
      asm volatile("s_waitcnt vmcnt(0)" ::: "memory");
      const unsigned og = xb_add(&bar[XB_TOP], 1u);
      const unsigned tg = og / nx;
      if (og + 1u == (tg + 1u) * nx) xb_add(&bar[XB_TOPGEN], 1u);
      else XB_SPIN(xb_ld(&bar[XB_TOPGEN]) == tg, bar);
      __builtin_amdgcn_fence(__ATOMIC_ACQUIRE, "agent");
      xb_add(&bar[XB_XGEN(x)], 1u);
      asm volatile("s_waitcnt vmcnt(0)" ::: "memory");
    } else {
      XB_SPIN(xb_ld(&bar[XB_XGEN(x)]) == gen, bar);
      __builtin_amdgcn_fence(__ATOMIC_ACQUIRE, "agent");
      asm volatile("s_waitcnt vmcnt(0)" ::: "memory");
    }
  }
  __syncthreads();
}

DI void run_phase(const Params& p, int ph, int spos, char* shm) {
  if (ph == 0) { U_INIT(phase_init(p, shm)); return; }
  const int layer = (ph - 1) / 9, sub = (ph - 1) % 9;
  const int bid = blockIdx.x, G = gridDim.x;
  int nj = 0, k0 = 0, k1 = 0, k2 = 0, s0 = 0, s1 = 1, s2 = 0, n0 = 0, n1 = 0, n2 = 0;
  if (sub == 0) { nj = 2; k0 = k1 = K_PROJ; n0 = 2048; n1 = 16; }
  else if (sub == 1) { nj = 3; k0 = k1 = K_Q; k2 = K_KV; n0 = 768; n1 = 6; n2 = 768; }
  else if (sub == 3) { nj = 2; k0 = k1 = K_GLU; n0 = 256; n1 = 2; }
  else if (sub == 4) { nj = 2; k0 = k1 = K_RES1; n0 = 1024; n1 = 32; }
  else if (sub == 6) { nj = 2; k0 = k1 = K_UP; n0 = 4096; n1 = 32; }
  else if (sub == 7) { nj = 2; k0 = k1 = K_RES2; n0 = 1024; n1 = 32; }
  if (nj > 0) {
    const int tot = n0 + n1 + n2;
    bool pre = false; Job cj = get_job(p, k0, layer, 0, 0); int cbr = 0, cbc = 0;
    auto decode = [&](int t, Job& j, int& br, int& bc) {
      int kind, samp, lt;
      if (t < n0) { kind = k0; samp = s0; lt = t; } else if (t < n0 + n1) { kind = k1; samp = s1; lt = t - n0; } else { kind = k2; samp = s2; lt = t - n0 - n1; }
      const bool spl = samp && (kind == K_RES1 || kind == K_RES2);
      j = get_job(p, kind, layer, samp, spl ? (lt >> 3) : 0);
      tile_coords(j, spl ? (lt & 7) : lt, br, bc);
    };
    if (bid < tot) decode(bid, cj, cbr, cbc);
    for (int t = bid; t < tot; t += G) {
      Job nj = cj; int nbr = 0, nbc = 0; const bool hasn = t + G < tot;
      if (hasn) decode(t + G, nj, nbr, nbc);
      U_GEMM(gemm_do_tile(p, cj, layer, cbr, cbc, pre, hasn, nj, nbr, nbc, shm));
      pre = hasn; cj = nj; cbr = nbr; cbc = nbc;
    }
  }
  if (sub == 1) {
    const int ns5 = 128, nrp = 2048, nrs = 16, nmp = 1024, nms = 8, ncc = 1024;
    const int e2 = ns5, e3 = e2 + nrp, e4 = e3 + nrs, e5 = e4 + nmp, e6 = e5 + nms, e7 = e6 + ncc;
    unsigned* pctr = (unsigned*)(p.ws + OFF_CTL) + spos * 16 + 9;
    int* su = (int*)(shm + SHM_MAIN + 1024);
    while (true) {
      if (ltid(p) == 0) *su = (int)atomicAdd(pctr, 1u);
      __syncthreads();
      const int t = *su;
      __syncthreads();
      if (t >= e7) break;
      if (t < e2) U_S5(s5_unit(p, layer, 0, t, 1, shm));
      else if (t < e4) { const int i = t - e2; U_RP(rwkv_prep_unit(p, layer, t >= e3, t < e3 ? ((i & 7) * 256 + 255 - (i >> 3)) : t - e3, shm)); }
      else if (t < e6) mla_prep_unit(p, layer, t >= e5, t < e5 ? t - e4 : t - e5);
      else U_CC(cache_conv_unit(p, layer, t - e6, shm));
      __syncthreads();
    }
  } else if (sub == 2) {
    unsigned* ctr = (unsigned*)(p.ws + OFF_CTL) + spos * 16;
    int* su = (int*)(shm + SHM_MAIN + 1024);
    const int nspec = 96 + 128 + 16 + 192 + 32;
    const int myx = blockIdx.x & 7;
    bool spec_done = false; int xk = 0;
    while (true) {
      if (ltid(p) == 0) {
        int u = -1;
        if (!spec_done) { const int a = (int)atomicAdd(ctr, 1u); if (a < nspec) u = a; }
        if (u < 0) {
          for (int k = xk; k < 8; ++k) { const int xx = (myx + k) & 7; const int a = (int)atomicAdd(ctr + 1 + xx, 1u);
            if (a < 96) { u = nspec + xx * 96 + a; break; } }
        }
        *su = u;
      }
      __syncthreads();
      const int u = *su;
      __syncthreads();
      if (u < 0) break;
      if (u >= nspec) { spec_done = true; }
      if (u < 96 || (u >= 240 && u < 432)) U_SCAN(rwkv_scan_unit(p, layer, u >= 96, u < 96 ? u : u - 240, shm));
      else if (u < 224 || (u >= 432 && u < nspec)) U_S5(s5_unit(p, layer, u >= 224, u < 224 ? u - 96 : u - 432, 2, shm));
      else if (u < 240) U_AS(attn_sample_unit(p, layer, u - 224, shm));
      else { const int v = u - nspec, xx = v / 96, a = v % 96; const int bh = xx * 6 + a / 16, qb = 15 - (a & 15);
        U_AP(attn_prompt_unit(p, bh, qb, shm)); }
      __syncthreads();
    }
  } else if (sub == 3) {
    rwkv_post(p, layer);
  } else if (sub == 5) {
    ln_rows(p, layer, 0, 0);
  } else if (sub == 8) {
    ln_rows(p, layer, 1, layer == 1);
  }
}

#ifndef SCHED_LIST
#define SCHED_LIST 0, 1, 2, 3, 4, 5, 6, 7, 8, 9, 10, 11, 12, 13, 14, 15, 16, 17, 18
#endif
__constant__ int c_sched[] = {SCHED_LIST};
constexpr int NSCHED = sizeof((int[]){SCHED_LIST}) / sizeof(int);

__global__ void __launch_bounds__(NT) mega(Params p, int ph_lo, int ph_hi) {
  __shared__ __attribute__((aligned(16))) char shm[SHM_BYTES];
  p.wave = __builtin_amdgcn_readfirstlane((int)(threadIdx.x >> 6));
#if MULTI
  for (int i = ph_lo; i < ph_hi; ++i) run_phase(p, c_sched[i], i, shm);
#else
  cg::grid_group grid = cg::this_grid();
  unsigned* bar = (unsigned*)(p.ws + OFF_BAR);
  const bool leader = (threadIdx.x == 0);
  if (leader) { volatile LAS unsigned* st = (volatile LAS unsigned*)(shm + SHM_MAIN + 1040); st[0] = 0u; st[1] = 0u; }
  __syncthreads();
  const unsigned xcc = xb_xcc_id();
  if (leader) (void)xb_add(&bar[XB_XCNT(xcc)], 1u);
  for (int i = ph_lo; i < ph_hi; ++i) {
    run_phase(p, c_sched[i], i, shm);
    if (i + 1 < ph_hi) {
      if (i == ph_lo) grid.sync();
      else xcd_barrier(bar, xcc, shm, p.wave == 0 && lane_id() == 0);
    }
  }
#endif
}

extern "C" void kernel_launch(void* const* d_in, const int* in_sizes, int n_in, void* d_out, int out_size, void* d_ws, size_t ws_size,
                              hipStream_t stream) {
  Params p{};
  _Pragma("unroll") for (int i = 0; i < 40; ++i) p.in[i] = (const float*)d_in[i];
  p.out = (float*)d_out; p.ws = (char*)d_ws;
  if (ws_size < WS_NEED) { fprintf(stderr, "workspace too small: %zu < %zu\n", ws_size, (size_t)WS_NEED); return; }
#if MULTI
  for (int ph = 0; ph < NSCHED; ++ph) {
    hipLaunchKernelGGL(mega, dim3(256), dim3(NT), 0, stream, p, ph, ph + 1);
  }
#else
  static int grid_blocks = 0;
  if (!grid_blocks) {
    int dev = 0, cus = 0, per_cu = 0;
    hipGetDevice(&dev);
    hipDeviceGetAttribute(&cus, hipDeviceAttributeMultiprocessorCount, dev);
    hipOccupancyMaxActiveBlocksPerMultiprocessor(&per_cu, mega, NT, 0);
    if (per_cu > 1) per_cu = 1;
    grid_blocks = cus * per_cu;
  }
  int lo = 0, hi = NSCHED;
  (void)hipMemsetAsync((char*)d_ws + OFF_BAR, 0, XCD_BAR_WORDS * 4, stream);
  void* args[] = {&p, &lo, &hi};
  hipError_t e = hipLaunchCooperativeKernel((void*)mega, dim3(grid_blocks), dim3(NT), args, 0, stream);
  if (e != hipSuccess) fprintf(stderr, "cooperative launch failed: %s (grid %d)\n", hipGetErrorString(e), grid_blocks);
#endif
}
```

```cpp
#include <hip/hip_runtime.h>
#include <hip/hip_cooperative_groups.h>
#include <stdint.h>
#include <cstdio>
namespace cg = cooperative_groups;

#ifndef MULTI
#define MULTI 0
#endif

#ifdef NO_SCAN
#define U_SCAN(x) do{}while(0)
#else
#define U_SCAN(x) x
#endif
#ifdef NO_S5
#define U_S5(x) do{}while(0)
#else
#define U_S5(x) x
#endif
#ifdef NO_AS
#define U_AS(x) do{}while(0)
#else
#define U_AS(x) x
#endif
#ifdef NO_AP
#define U_AP(x) do{}while(0)
#else
#define U_AP(x) x
#endif
#ifdef NO_RP
#define U_RP(x) do{}while(0)
#else
#define U_RP(x) x
#endif
#ifdef NO_GEMM
#define U_GEMM(x) do{}while(0)
#else
#define U_GEMM(x) x
#endif
#ifdef NO_INIT
#define U_INIT(x) do{}while(0)
#else
#define U_INIT(x) x
#endif
#ifdef NO_CC
#define U_CC(x) do{}while(0)
#else
#define U_CC(x) x
#endif
#define DI __device__ __forceinline__
typedef unsigned short bfu;
using bf16x8 = __attribute__((ext_vector_type(8))) short;
using s16x4  = __attribute__((ext_vector_type(4))) short;
using f32x4  = __attribute__((ext_vector_type(4))) float;
using f32x16 = __attribute__((ext_vector_type(16))) float;

constexpr int NT = 512;
constexpr int MP = 65536, MS = 512, SP = 8192, TS = 32, SKP = 4160, SKS = 4128;
constexpr float ALPHA = 1.4142135623730951f;
constexpr float QSCALE = 0.10206207261596575f * 1.4426950408889634f;
constexpr size_t MiB = 1048576;

constexpr size_t LW_WIN = 0;
constexpr size_t LW_WQB = LW_WIN + (size_t)2048 * 1024 * 2;
constexpr size_t LW_WKV = LW_WQB + 768 * 256 * 2;
constexpr size_t LW_WGLU = LW_WKV + 768 * 128 * 2;
constexpr size_t LW_WOUT = LW_WGLU + 256 * 256 * 2;
constexpr size_t LW_WUP = LW_WOUT + 1024 * 1024 * 2;
constexpr size_t LW_WDN = LW_WUP + (size_t)4096 * 1024 * 2;
constexpr size_t LW_LORA = LW_WDN + (size_t)4096 * 1024 * 2;
constexpr size_t LW_STRIDE = 23 * MiB;
static_assert(LW_LORA + 384 * 128 * 2 <= LW_STRIDE, "weights region");
constexpr size_t OFF_X = 46 * MiB;
constexpr size_t OFF_XS = 174 * MiB;
constexpr size_t OFF_TAB = 175 * MiB;
constexpr size_t OFF_CTL = 176 * MiB;
constexpr size_t OFF_SS = 177 * MiB;
constexpr size_t OFF_P = 233 * MiB;
constexpr size_t S_QL = OFF_SS;
constexpr size_t S_KVL = S_QL + 512 * 256 * 2;
constexpr size_t S_U = S_KVL + 512 * 160 * 2;
constexpr size_t S_PR = S_U + 512 * 256 * 2;
constexpr size_t S_Q = S_PR + 512 * 1280 * 2;
constexpr size_t S_QABS = S_Q + 512 * 576 * 2;
constexpr size_t S_RW = S_QABS + 16 * 6 * 32 * 160 * 2;
constexpr size_t S_G = S_RW + 16 * 6 * 32 * 384 * 2;
constexpr size_t S_BON = S_G + 512 * 384 * 2;
constexpr size_t S_Y = S_BON + 512 * 6 * 4;
constexpr size_t S_MERGED = S_Y + 512 * 384 * 2;
constexpr size_t S_Z = S_MERGED + 512 * 1024 * 2;
constexpr size_t S_HID = S_Z + 512 * 1024 * 4;
constexpr size_t S_KCAT = S_HID + 512 * 4096 * 2;
constexpr size_t S_VT = S_KCAT + (size_t)16 * SKP * 160 * 2;
constexpr size_t S_ZS5 = S_VT + (size_t)16 * 128 * SKP * 2;
constexpr size_t S_END = S_ZS5 + 512 * 256 * 2;
static_assert(S_END <= OFF_P, "sample scratch overflow");
constexpr size_t P_QL = OFF_P;
constexpr size_t P_KVL = OFF_P + 32 * MiB;
constexpr size_t P_PR = OFF_P + 52 * MiB;
constexpr size_t P_U = OFF_P + 212 * MiB;
constexpr size_t P_Q = OFF_P + 244 * MiB;
constexpr size_t P_KB = OFF_P + 316 * MiB;
constexpr size_t P_VT = OFF_P + 388 * MiB;
constexpr size_t P_RW = OFF_P + 436 * MiB;
constexpr size_t P_G = OFF_P + 724 * MiB;
constexpr size_t P_BON = OFF_P + 772 * MiB;
constexpr size_t P_MERGED = OFF_P;
constexpr size_t P_Y = OFF_P + 128 * MiB;
constexpr size_t P_ZS5 = OFF_P + 176 * MiB;
constexpr size_t P_Z1 = OFF_P + 212 * MiB;
constexpr size_t P_HID = OFF_P;
constexpr size_t P_Z2 = OFF_P + 512 * MiB;
constexpr size_t P_SZP = OFF_P + 768 * MiB;
constexpr size_t WS_NEED = OFF_P + 776 * MiB;

constexpr size_t O_YP = 0;
constexpr size_t O_YS = 67108864;
constexpr size_t O_CKVP = O_YS + 524288;
constexpr size_t O_KRP = O_CKVP + 16777216;
constexpr size_t O_S5P = O_KRP + 4194304;
constexpr size_t O_RWP = O_S5P + 32768;
constexpr size_t O_SHP = O_RWP + 393216;
constexpr size_t O_CKVS = O_SHP + 20480;
constexpr size_t O_KRS = O_CKVS + 131072;
constexpr size_t O_S5S = O_KRS + 32768;
constexpr size_t O_RWS = O_S5S + 65536;
constexpr size_t O_SHS = O_RWS + 786432;

enum { I_XP = 0, I_XS, I_CCKV, I_CKR, I_SS5, I_SRW, I_SSH, I_WIN, I_QG, I_WQB, I_KVG, I_WKVB, I_LRE, I_LIM, I_LDT, I_BRE, I_BIM,
       I_CRE, I_CIM, I_S5D, I_WGLU, I_BGLU, I_MU, I_W0, I_WW2, I_A0, I_WA2, I_WG2, I_KK, I_KA, I_RK, I_GNG, I_GNB, I_WOUT,
       I_LN1G, I_LN1B, I_WUP, I_WDN, I_LN2G, I_LN2B };

struct Params { const float* in[40]; float* out; char* ws; int wave; int pad_; };
DI int opaque0() { int z; asm volatile("s_mov_b32 %0, 0" : "=s"(z)); return z; }
DI int lane_id() { return (int)__builtin_amdgcn_mbcnt_hi(~0u, __builtin_amdgcn_mbcnt_lo(~0u, 0u)); }
DI int ltid(const Params& p) { int t = p.wave * 64 + lane_id(); asm volatile("" : "+v"(t)); return t; }
DI Params relaunder(const Params& p) {
  Params q; const int z = opaque0();
  _Pragma("unroll") for (int i = 0; i < 40; ++i) q.in[i] = p.in[i] + z;
  q.out = p.out + z; q.ws = p.ws + z; q.wave = p.wave + z; q.pad_ = 0; return q;
}


constexpr int SHM_MAIN = 131072;
constexpr int SHM_BYTES = SHM_MAIN + 2048;

DI float bf2f(bfu x) { return __uint_as_float(((unsigned)x) << 16); }
DI bfu f2bf(float f) { __bf16 b = (__bf16)f; return __builtin_bit_cast(unsigned short, b); }
DI unsigned pack2(float a, float b) { return (unsigned)f2bf(a) | ((unsigned)f2bf(b) << 16); }

template <int CTRL> DI float dppf(float x) { return __int_as_float(__builtin_amdgcn_update_dpp(0, __float_as_int(x), CTRL, 0xF, 0xF, false)); }
DI float allred16(float x) { x += dppf<0x128>(x); x += dppf<0x124>(x); x += dppf<0x122>(x); x += dppf<0x121>(x); return x; }
DI float wave_sum(float v) {
  v = allred16(v);
  const int iv = __float_as_int(v);
  return __int_as_float(__builtin_amdgcn_readlane(iv, 0)) + __int_as_float(__builtin_amdgcn_readlane(iv, 16)) +
         __int_as_float(__builtin_amdgcn_readlane(iv, 32)) + __int_as_float(__builtin_amdgcn_readlane(iv, 48));
}
DI float sigmoidf_(float x) { return __builtin_amdgcn_rcpf(1.f + __expf(-x)); }
DI float tanhf_(float x) { return 1.f - 2.f * __builtin_amdgcn_rcpf(__expf(2.f * x) + 1.f); }
DI int crow(int reg, int h) { return (reg & 3) + 8 * (reg >> 2) + 4 * h; }

DI void tr_weight(const float* src, int K, int N, int Np, const float* scale, bfu* dst, char* shm, const int tid) {
  float* tile = (float*)shm;
  const int ntk = K / 64, ntn = Np / 64;
  for (int t = blockIdx.x; t < ntk * ntn; t += gridDim.x) {
    const int k0 = (t % ntk) * 64, n0 = (t / ntk) * 64;
    for (int e = tid; e < 4096; e += NT) {
      int r = e >> 6, c = e & 63;
      float v = 0.f;
      if (n0 + c < N) { v = src[(long)(k0 + r) * N + n0 + c]; if (scale) v *= scale[k0 + r]; }
      tile[r * 65 + c] = v;
    }
    __syncthreads();
    for (int e = tid; e < 4096; e += NT) {
      int rn = e >> 6, ck = e & 63;
      dst[(long)(n0 + rn) * K + k0 + ck] = f2bf(tile[ck * 65 + rn]);
    }
    __syncthreads();
  }
}

DI void phase_init(const Params& pin, char* shm) {
  const Params p = relaunder(pin);
  const int tid = ltid(p);
  const long gtid = (long)blockIdx.x * NT + tid, gsz = (long)gridDim.x * NT;
  if (blockIdx.x == 0) for (int i = tid; i < 1024; i += NT) ((unsigned*)(p.ws + OFF_CTL))[i] = 0u;
  float2* tab = (float2*)(p.ws + OFF_TAB);
  for (long i = gtid; i < 8192 * 16; i += gsz) {
    int pos = (int)(i >> 4), k = (int)(i & 15);
    const float inv = exp2f(-(float)k * 0.8304820237218406f);
    const float ang = (float)pos * inv;
    const float s = sinf(ang), c = cosf(ang);
    tab[i] = make_float2(c, s);
  }
  for (int l = 0; l < 2; ++l) {
    char* wb = p.ws + l * LW_STRIDE;
    tr_weight(p.in[I_WIN] + (size_t)l * 1024 * 1952, 1024, 1952, 2048, nullptr, (bfu*)(wb + LW_WIN), shm, tid);
    tr_weight(p.in[I_WQB] + (size_t)l * 256 * 576, 256, 576, 768, p.in[I_QG] + l * 256, (bfu*)(wb + LW_WQB), shm, tid);
    tr_weight(p.in[I_WKVB] + (size_t)l * 128 * 768, 128, 768, 768, p.in[I_KVG] + l * 128, (bfu*)(wb + LW_WKV), shm, tid);
    tr_weight(p.in[I_WGLU] + (size_t)l * 256 * 256, 256, 256, 256, nullptr, (bfu*)(wb + LW_WGLU), shm, tid);
    tr_weight(p.in[I_WOUT] + (size_t)l * 1024 * 1024, 1024, 1024, 1024, nullptr, (bfu*)(wb + LW_WOUT), shm, tid);
    tr_weight(p.in[I_WUP] + (size_t)l * 1024 * 4096, 1024, 4096, 4096, nullptr, (bfu*)(wb + LW_WUP), shm, tid);
    tr_weight(p.in[I_WDN] + (size_t)l * 4096 * 1024, 4096, 1024, 1024, nullptr, (bfu*)(wb + LW_WDN), shm, tid);
    { bfu* WL = (bfu*)(wb + LW_LORA);
      const float* W2 = p.in[I_WW2] + (size_t)l * 32 * 384, *A2 = p.in[I_WA2] + (size_t)l * 32 * 384, *G2 = p.in[I_WG2] + (size_t)l * 64 * 384;
      for (long i = gtid; i < 384 * 128; i += gsz) { const int n = (int)(i >> 7), k = (int)(i & 127);
        const float v = (k < 32) ? W2[k * 384 + n] : (k < 64 ? A2[(k - 32) * 384 + n] : G2[(k - 64) * 384 + n]);
        WL[i] = f2bf(v); } }
  }
  {
    const float4* xp = (const float4*)p.in[I_XP]; uint2* X = (uint2*)(p.ws + OFF_X);
    for (long i = gtid; i < (long)MP * 256; i += gsz) { float4 v = xp[i]; X[i] = make_uint2(pack2(v.x, v.y), pack2(v.z, v.w)); }
    const float4* xs = (const float4*)p.in[I_XS]; uint2* XS = (uint2*)(p.ws + OFF_XS);
    for (long i = gtid; i < (long)MS * 256; i += gsz) { float4 v = xs[i]; XS[i] = make_uint2(pack2(v.x, v.y), pack2(v.z, v.w)); }
  }
}

constexpr int BM = 256, BK = 64, HALF = 128, NXCD = 8, WGM = 8, HT = HALF * BK;
DI int lds_byte(int r, int c) {
  int st = (r >> 4) * 2 + (c >> 5), rr = r & 15, cc = c & 31, ob = rr * 64 + cc * 2;
  return st * 1024 + (ob ^ (((ob >> 9) & 1) << 5));
}
DI void stage_rc(int b, int& R, int& C) {
  int st = b / 1024, sb = b % 1024, swz = sb ^ (((sb >> 9) & 1) << 5);
  R = (st >> 1) * 16 + swz / 64; C = (st & 1) * 32 + (swz % 64) / 2;
}
enum { K_PROJ = 0, K_Q, K_KV, K_GLU, K_RES1, K_UP, K_RES2 };
struct Job { const bfu* A; const bfu* Bt; int lda, ldb, M, N, K, kind, samp, split; };

DI void gemm_tile(const bfu* A, const bfu* Bt, const int lda, const int ldb, const int K, const int brow, const int bcol,
                  bfu* shm, f32x4 (&acc)[2][2][4][2], const int tidg, const bool pre) {
#define SA(b, h) (shm + ((b) * 2 + (h)) * HT)
#define SB(b, h) (shm + (4 + (b) * 2 + (h)) * HT)
#define STAGE(P, BASE, LD, OFF, br, kt) do { const char* _gb = (const char*)((BASE) + ((long)(br) * (LD) + (long)(kt) * BK)); \
    asm volatile("" : "+s"(_gb)); \
    _Pragma("unroll") for (int _i = 0; _i < 2; ++_i) { \
      __builtin_amdgcn_global_load_lds((const unsigned*)(_gb + (long)_i * 128 * (LD) + OFF), \
        (__attribute__((address_space(3))) unsigned*)((char*)(P) + wv1024 + _i * 8192), 16, 0, 0); } } while (0)
#define LDA(dst, b, h) _Pragma("unroll") for (int m = 0; m < 4; ++m) _Pragma("unroll") for (int k = 0; k < 2; ++k) \
    dst[m][k] = *reinterpret_cast<const bf16x8*>((const char*)SA(b, h) + la + (m * 2048 + k * 1024))
#define LDB(dst, b, h) _Pragma("unroll") for (int n = 0; n < 2; ++n) _Pragma("unroll") for (int k = 0; k < 2; ++k) \
    dst[n][k] = *reinterpret_cast<const bf16x8*>((const char*)SB(b, h) + lb + (n * 2048 + k * 1024))
#define MMA(ai, bj, At, Bx) do { __builtin_amdgcn_s_setprio(1); \
    _Pragma("unroll") for (int m = 0; m < 4; ++m) _Pragma("unroll") for (int n = 0; n < 2; ++n) _Pragma("unroll") for (int k = 0; k < 2; ++k) \
      acc[ai][bj][m][n] = __builtin_amdgcn_mfma_f32_16x16x32_bf16(At[m][k], Bx[n][k], acc[ai][bj][m][n], 0, 0, 0); \
    __builtin_amdgcn_s_setprio(0); } while (0)
#define WAIT_V(n) asm volatile("s_waitcnt vmcnt(" #n ")" ::: "memory")
#define WAIT_L(n) asm volatile("s_waitcnt lgkmcnt(" #n ")" ::: "memory")
#define BAR __builtin_amdgcn_s_barrier()
#define SCHED __builtin_amdgcn_sched_barrier(0)
  const int tb16 = tidg * 16;
  const int wv1024 = __builtin_amdgcn_readfirstlane(tidg >> 6) * 1024;
  const int wid = tidg >> 6, lane = tidg & 63, wr = wid >> 2, wc = wid & 3, fr = lane & 15, fq = lane >> 4;
  _Pragma("unroll") for (int a = 0; a < 2; ++a) _Pragma("unroll") for (int b = 0; b < 2; ++b) _Pragma("unroll") for (int m = 0; m < 4; ++m) _Pragma("unroll") for (int n = 0; n < 2; ++n) acc[a][b][m][n] = f32x4{0.f, 0.f, 0.f, 0.f};
  bf16x8 At[4][2], B0[2][2], B1[2][2];
  const int nt = K / BK;
  unsigned aoff, boff;
  { int _r, _c; stage_rc(tb16, _r, _c); aoff = (unsigned)(_r * lda + _c) * 2u; boff = (unsigned)(_r * ldb + _c) * 2u; }
  const int sw_ = (fr * 64 + fq * 16) ^ ((((fr * 64 + fq * 16) >> 9) & 1) << 5);
  const int la = wr * 8192 + sw_, lb = wc * 4096 + sw_;
  if (!pre) {
    STAGE(SB(0, 0), Bt, ldb, boff, bcol, 0); STAGE(SA(0, 0), A, lda, aoff, brow, 0);
    STAGE(SB(0, 1), Bt, ldb, boff, bcol + HALF, 0); STAGE(SA(0, 1), A, lda, aoff, brow + HALF, 0);
    if (wr == 1) BAR;
    WAIT_V(4); BAR;
    STAGE(SB(1, 0), Bt, ldb, boff, bcol, 1); STAGE(SA(1, 0), A, lda, aoff, brow, 1); STAGE(SB(1, 1), Bt, ldb, boff, bcol + HALF, 1);
    WAIT_V(6); BAR;
  } else {
    WAIT_V(0);
    if (wr == 1) BAR;
    BAR; BAR;
  }
  for (int t = 0; t < nt - 2; t += 2) {
    LDB(B0, 0, 0); SCHED; LDA(At, 0, 0); STAGE(SA(1, 1), A, lda, aoff, brow + HALF, t + 1);
    WAIT_L(8); BAR; WAIT_L(0); MMA(0, 0, At, B0); BAR; SCHED;
    LDB(B1, 0, 1); STAGE(SB(0, 0), Bt, ldb, boff, bcol, t + 2);
    BAR; WAIT_L(0); MMA(0, 1, At, B1); BAR;
    LDA(At, 0, 1); STAGE(SA(0, 0), A, lda, aoff, brow, t + 2);
    BAR; WAIT_L(0); MMA(1, 0, At, B0); BAR; SCHED;
    STAGE(SB(0, 1), Bt, ldb, boff, bcol + HALF, t + 2);
    WAIT_V(6); BAR; MMA(1, 1, At, B1); BAR;
    LDB(B0, 1, 0); SCHED; LDA(At, 1, 0); STAGE(SA(0, 1), A, lda, aoff, brow + HALF, t + 2);
    WAIT_L(8); BAR; WAIT_L(0); MMA(0, 0, At, B0); BAR; SCHED;
    LDB(B1, 1, 1); STAGE(SB(1, 0), Bt, ldb, boff, bcol, t + 3);
    BAR; WAIT_L(0); MMA(0, 1, At, B1); BAR;
    LDA(At, 1, 1); STAGE(SA(1, 0), A, lda, aoff, brow, t + 3);
    BAR; WAIT_L(0); MMA(1, 0, At, B0); BAR; SCHED;
    STAGE(SB(1, 1), Bt, ldb, boff, bcol + HALF, t + 3);
    WAIT_V(6); BAR; MMA(1, 1, At, B1); BAR;
  }
  { LDB(B0, 0, 0); LDA(At, 0, 0); STAGE(SA(1, 1), A, lda, aoff, brow + HALF, nt - 1);
    BAR; WAIT_L(0); MMA(0, 0, At, B0); BAR;
    LDB(B1, 0, 1); BAR; WAIT_L(0); MMA(0, 1, At, B1); BAR;
    LDA(At, 0, 1); WAIT_V(4); BAR; WAIT_L(0); MMA(1, 0, At, B0); MMA(1, 1, At, B1); BAR; }
  { LDB(B0, 1, 0); LDA(At, 1, 0); WAIT_V(2); BAR; WAIT_L(0); MMA(0, 0, At, B0); BAR;
    LDB(B1, 1, 1); WAIT_V(0); BAR; WAIT_L(0); MMA(0, 1, At, B1); BAR;
    LDA(At, 1, 1); BAR; WAIT_L(0); MMA(1, 0, At, B0); MMA(1, 1, At, B1); BAR; }
  if (wr == 0) BAR;
}
DI void gemm_issue(const bfu* A, const bfu* Bt, const int lda, const int ldb, const int brow, const int bcol, bfu* shm, const int tidg) {
  const int tb16 = tidg * 16;
  const int wv1024 = __builtin_amdgcn_readfirstlane(tidg >> 6) * 1024;
  unsigned aoff, boff;
  { int _r, _c; stage_rc(tb16, _r, _c); aoff = (unsigned)(_r * lda + _c) * 2u; boff = (unsigned)(_r * ldb + _c) * 2u; }
  STAGE(SB(0, 0), Bt, ldb, boff, bcol, 0); STAGE(SA(0, 0), A, lda, aoff, brow, 0);
  STAGE(SB(0, 1), Bt, ldb, boff, bcol + HALF, 0); STAGE(SA(0, 1), A, lda, aoff, brow + HALF, 0);
  STAGE(SB(1, 0), Bt, ldb, boff, bcol, 1); STAGE(SA(1, 0), A, lda, aoff, brow, 1); STAGE(SB(1, 1), Bt, ldb, boff, bcol + HALF, 1);
}

template <class F>
DI void epi_loop(f32x4 (&acc)[2][2][4][2], int wr, int wc, int fq, F f) {
  _Pragma("unroll") for (int ai = 0; ai < 2; ++ai) _Pragma("unroll") for (int bj = 0; bj < 2; ++bj) _Pragma("unroll") for (int m = 0; m < 4; ++m)
    f(ai * 128 + wr * 64 + m * 16 + fq * 4, bj * 128 + wc * 32, acc[ai][bj][m][0], acc[ai][bj][m][1]);
}

DI f32x4 quad_tr(f32x4 v, const bool o1, const bool o2) {
  const float s0 = o1 ? v[0] : v[1], s1 = o1 ? v[2] : v[3];
  const float r0 = dppf<0xB1>(s0), r1 = dppf<0xB1>(s1);
  if (o1) { v[0] = r0; v[2] = r1; } else { v[1] = r0; v[3] = r1; }
  const float t0 = o2 ? v[0] : v[2], t1 = o2 ? v[1] : v[3];
  const float q0 = dppf<0x4E>(t0), q1 = dppf<0x4E>(t1);
  if (o2) { v[0] = q0; v[1] = q1; } else { v[2] = q0; v[3] = q1; }
  return v;
}

DI void gemm_epilogue(const Params& pin, const Job& jb, int layer, int brow, int bcol, f32x4 (&acc)[2][2][4][2], const float* rs) {
  const Params p = relaunder(pin);
  const int tide = ltid(p);
  const int wid = tide >> 6, lane = tide & 63, wr = wid >> 2, wc = wid & 3, fr = lane & 15, fq = lane >> 4;
  const int samp = jb.samp, T = samp ? TS : SP, LT = samp ? 5 : 13, kind = jb.kind;
  const bool o1 = lane & 1, o2 = lane & 2; const int fl = fr & 3, fc = fr & 12;
  char* ws = p.ws;
  if (kind == K_PROJ) {
    bfu* QL = (bfu*)(ws + (samp ? S_QL : P_QL)); bfu* KVL = (bfu*)(ws + (samp ? S_KVL : P_KVL));
    bfu* U = (bfu*)(ws + (samp ? S_U : P_U)); bfu* PR = (bfu*)(ws + (samp ? S_PR : P_PR));
    float* osh = p.out + (samp ? O_SHS : O_SHP) + (size_t)layer * (samp ? 16 : 8) * 1280;
    epi_loop(acc, wr, wc, fq, [&](int rl, int cbl, const f32x4& v0, const f32x4& v1) {
      const int r = brow + rl + fl;
      _Pragma("unroll") for (int n = 0; n < 2; ++n) {
        const f32x4 v = quad_tr(n ? v1 : v0, o1, o2);
        const int c = bcol + cbl + n * 16 + fc;
        const uint2 pk = make_uint2(pack2(v[0], v[1]), pack2(v[2], v[3]));
        if (c < 256) *(uint2*)(QL + (long)r * 256 + c) = pk;
        else if (c < 416) *(uint2*)(KVL + (long)r * 160 + (c - 256)) = pk;
        else if (c < 672) *(uint2*)(U + (long)r * 256 + (c - 416)) = pk;
        else if (c < 1952) {
          *(uint2*)(PR + (long)r * 1280 + (c - 672)) = pk;
          if ((r & (T - 1)) == T - 1) *(float4*)(osh + (size_t)(r >> LT) * 1280 + (c - 672)) = make_float4(v[0], v[1], v[2], v[3]);
        }
      }
    });
  } else if (kind == K_KV) {
    bfu* KB = (bfu*)(ws + P_KB); bfu* VT = (bfu*)(ws + P_VT);
    epi_loop(acc, wr, wc, fq, [&](int rl, int cbl, const f32x4& v0, const f32x4& v1) {
      const int r0 = brow + rl; const int b = r0 >> 13, t0 = r0 & (SP - 1);
      const int cg16 = bcol + cbl; const int h = cg16 >> 7;
      if ((cg16 & 64) == 0) {
        const float s = rs[rl + fl];
        _Pragma("unroll") for (int n = 0; n < 2; ++n) {
          const f32x4 v = quad_tr(n ? v1 : v0, o1, o2);
          const int w = (cg16 & 127) + n * 16 + fc;
          *(uint2*)(KB + ((long)(b * 6 + h) * SP + t0 + fl) * 96 + w) = make_uint2(pack2(v[0] * s, v[1] * s), pack2(v[2] * s, v[3] * s));
        }
      } else {
        const float s0 = rs[rl], s1 = rs[rl + 1], s2 = rs[rl + 2], s3 = rs[rl + 3];
        _Pragma("unroll") for (int n = 0; n < 2; ++n) {
          const f32x4 v = n ? v1 : v0;
          const int w = (cg16 & 63) + n * 16 + fr;
          *(uint2*)(VT + ((long)(b * 6 + h) * 64 + w) * SP + t0) = make_uint2(pack2(v[0] * s0, v[1] * s1), pack2(v[2] * s2, v[3] * s3));
        }
      }
    });
  } else if (kind == K_GLU) {
    const bfu* U = (const bfu*)(ws + (samp ? S_ZS5 : P_ZS5)); bfu* MG = (bfu*)(ws + (samp ? S_MERGED : P_MERGED));
    const float* bgl = p.in[I_BGLU] + layer * 256;
    epi_loop(acc, wr, wc, fq, [&](int rl, int cbl, const f32x4& v0, const f32x4& v1) {
      const long r = brow + rl + fl;
      _Pragma("unroll") for (int n = 0; n < 2; ++n) {
        const f32x4 v = quad_tr(n ? v1 : v0, o1, o2);
        const int c = bcol + cbl + n * 16 + fc;
        const float4 bg = *(const float4*)(bgl + c);
        const uint2 zu = *(const uint2*)(U + r * 256 + c);
        const float z0 = bf2f(zu.x & 0xffff), z1 = bf2f(zu.x >> 16), z2 = bf2f(zu.y & 0xffff), z3 = bf2f(zu.y >> 16);
        *(uint2*)(MG + r * 1024 + 384 + c) = make_uint2(pack2(z0 * sigmoidf_(v[0] + bg.x), z1 * sigmoidf_(v[1] + bg.y)),
                                                        pack2(z2 * sigmoidf_(v[2] + bg.z), z3 * sigmoidf_(v[3] + bg.w)));
      }
    });
  } else if (kind == K_RES1 || kind == K_RES2) {
    float* Z = samp ? (float*)(ws + P_SZP) + (size_t)jb.split * 512 * 1024 : (float*)(ws + (kind == K_RES1 ? P_Z1 : P_Z2));
    const bfu* X = (const bfu*)(ws + (samp ? OFF_XS : OFF_X));
    const float al = (samp && jb.split != 0) ? 0.f : ALPHA;
    epi_loop(acc, wr, wc, fq, [&](int rl, int cbl, const f32x4& v0, const f32x4& v1) {
      const long r = brow + rl + fl;
      _Pragma("unroll") for (int n = 0; n < 2; ++n) {
        const f32x4 v = quad_tr(n ? v1 : v0, o1, o2);
        const int c = bcol + cbl + n * 16 + fc;
        const uint2 xu = *(const uint2*)(X + r * 1024 + c);
        *(float4*)(Z + r * 1024 + c) = make_float4(al * bf2f(xu.x & 0xffff) + v[0], al * bf2f(xu.x >> 16) + v[1],
                                                   al * bf2f(xu.y & 0xffff) + v[2], al * bf2f(xu.y >> 16) + v[3]);
      }
    });
  } else if (kind == K_UP) {
    bfu* H = (bfu*)(ws + (samp ? S_HID : P_HID));
    epi_loop(acc, wr, wc, fq, [&](int rl, int cbl, const f32x4& v0, const f32x4& v1) {
      const long r = brow + rl + fl;
      _Pragma("unroll") for (int n = 0; n < 2; ++n) {
        const f32x4 v = quad_tr(n ? v1 : v0, o1, o2);
        const int c = bcol + cbl + n * 16 + fc;
        const float x0 = fmaxf(v[0], 0.f), x1 = fmaxf(v[1], 0.f), x2 = fmaxf(v[2], 0.f), x3 = fmaxf(v[3], 0.f);
        *(uint2*)(H + r * 4096 + c) = make_uint2(pack2(x0 * x0, x1 * x1), pack2(x2 * x2, x3 * x3));
      }
    });
  } else {
    bfu* Q = (bfu*)(ws + (samp ? S_Q : P_Q));
    const float2* tab = (const float2*)(ws + OFF_TAB);
    epi_loop(acc, wr, wc, fq, [&](int rl, int cbl, const f32x4& v0, const f32x4& v1) {
      const int cb = bcol + cbl;
      if (cb < 576) {
        const int r = brow + rl + fl; const float s = rs[rl + fl];
        const bool rope = (cb % 96) == 64;
        f32x4 a = quad_tr(v0, o1, o2), b = quad_tr(v1, o1, o2);
        _Pragma("unroll") for (int k = 0; k < 4; ++k) { a[k] *= s; b[k] *= s; }
        if (rope) { const int pos = (r & (T - 1)) + (samp ? 4096 : 0);
          _Pragma("unroll") for (int k = 0; k < 4; ++k) { const float2 cs = tab[pos * 16 + fc + k];
            const float a2 = a[k] * cs.x - b[k] * cs.y, b2 = b[k] * cs.x + a[k] * cs.y; a[k] = a2; b[k] = b2; } }
        *(uint2*)(Q + (long)r * 576 + cb + fc) = make_uint2(pack2(a[0], a[1]), pack2(a[2], a[3]));
        *(uint2*)(Q + (long)r * 576 + cb + 16 + fc) = make_uint2(pack2(b[0], b[1]), pack2(b[2], b[3]));
      }
    });
  }
}

DI Job get_job(const Params& pin, int kind, int layer, int samp, int split) {
  const Params p = relaunder(pin);
  char* ws = p.ws; char* wb = ws + layer * LW_STRIDE;
  Job j; j.kind = kind; j.samp = samp; j.M = samp ? MS : MP; j.split = split;
  switch (kind) {
    case K_PROJ: j.A = (const bfu*)(ws + (samp ? OFF_XS : OFF_X)); j.lda = 1024; j.Bt = (const bfu*)(wb + LW_WIN); j.ldb = 1024; j.N = 2048; j.K = 1024; break;
    case K_Q: j.A = (const bfu*)(ws + (samp ? S_QL : P_QL)); j.lda = 256; j.Bt = (const bfu*)(wb + LW_WQB); j.ldb = 256; j.N = 768; j.K = 256; break;
    case K_KV: j.A = (const bfu*)(ws + P_KVL); j.lda = 160; j.Bt = (const bfu*)(wb + LW_WKV); j.ldb = 128; j.N = 768; j.K = 128; break;
    case K_GLU: j.A = (const bfu*)(ws + (samp ? S_ZS5 : P_ZS5)); j.lda = 256; j.Bt = (const bfu*)(wb + LW_WGLU); j.ldb = 256; j.N = 256; j.K = 256; break;
    case K_RES1: j.A = (const bfu*)(ws + (samp ? S_MERGED : P_MERGED)); j.lda = 1024; j.Bt = (const bfu*)(wb + LW_WOUT); j.ldb = 1024; j.N = 1024; j.K = 1024; break;
    case K_UP: j.A = (const bfu*)(ws + (samp ? OFF_XS : OFF_X)); j.lda = 1024; j.Bt = (const bfu*)(wb + LW_WUP); j.ldb = 1024; j.N = 4096; j.K = 1024; break;
    default: j.A = (const bfu*)(ws + (samp ? S_HID : P_HID)); j.lda = 4096; j.Bt = (const bfu*)(wb + LW_WDN); j.ldb = 4096; j.N = 1024; j.K = 4096; break;
  }
  if (samp && (kind == K_RES1 || kind == K_RES2)) { j.K /= 4; j.A += split * j.K; j.Bt += split * j.K; }
  return j;
}

DI void tile_coords(const Job& jb, int wgid, int& brow, int& bcol) {
  const int nM = jb.M / BM, nN = jb.N / BM, nwg = nM * nN;
  if (jb.kind == K_RES2 && !jb.samp) wgid = nwg - 1 - wgid;
  { int q = nwg / NXCD, r = nwg % NXCD, xcd = wgid % NXCD, off = wgid / NXCD;
    wgid = (xcd < r ? xcd * (q + 1) : r * (q + 1) + (xcd - r) * q) + off; }
  const int nig = WGM * nN, gid = wgid / nig, fm = gid * WGM, gsz = min(nM - fm, WGM);
  const int pm = fm + ((wgid % nig) % gsz), pn = (wgid % nig) / gsz; brow = pm * BM; bcol = pn * BM;
}
DI void gemm_do_tile(const Params& pin, const Job& jb, int layer, int brow, int bcol, bool pre, bool hasn, const Job& nj, int nbrow, int nbcol, char* shm) {
  const Params p = relaunder(pin);
  f32x4 acc[2][2][4][2];
  const int tg = ltid(p);
  gemm_tile(jb.A, jb.Bt, jb.lda, jb.ldb, jb.K, brow, bcol, (bfu*)shm, acc, tg, pre);
  if (hasn) gemm_issue(nj.A, nj.Bt, nj.lda, nj.ldb, nbrow, nbcol, (bfu*)shm, tg);
  float* rs = (float*)(shm + SHM_MAIN);
  if (jb.kind == K_Q || jb.kind == K_KV) {
    const int tid = ltid(p), row = tid >> 1, half = tid & 1, kh = jb.K / 2;
    const bfu* ap = jb.A + (long)(brow + row) * jb.lda + half * kh;
    float ss = 0.f;
    for (int i = 0; i < kh; i += 8) { uint4 u = *(const uint4*)(ap + i);
      unsigned w[4] = {u.x, u.y, u.z, u.w};
      _Pragma("unroll") for (int k = 0; k < 4; ++k) { float a = bf2f(w[k] & 0xffff), b = bf2f(w[k] >> 16); ss += a * a + b * b; } }
    ss += __shfl_xor(ss, 1);
    float inv = rsqrtf(ss / (float)jb.K + 1e-6f);
    if (jb.kind == K_Q) inv *= QSCALE;
    if (half == 0) rs[row] = inv;
  }
  __syncthreads();
  gemm_epilogue(p, jb, layer, brow, bcol, acc, rs);
  __syncthreads();
}

DI void ln_rows(const Params& pin, int layer, int which  , int final_) {
  const Params p = relaunder(pin);
  const int tidw = ltid(p); const int wave = tidw >> 6, lane = tidw & 63;
  const float* g = p.in[which ? I_LN2G : I_LN1G] + layer * 1024;
  const float* bta = p.in[which ? I_LN2B : I_LN1B] + layer * 1024;
  for (int rr0 = (blockIdx.x * 8 + wave) * 2; rr0 < MP + MS; rr0 += gridDim.x * 16) {
    const int row0 = MP + MS - 2 - rr0;
    float4 v[2][4]; float s[2];
    _Pragma("unroll") for (int q = 0; q < 2; ++q) {
      const int row = row0 + q; const int samp = row >= MP; const long r = samp ? row - MP : row;
      const float* Z = (const float*)(p.ws + (samp ? P_SZP : (which ? P_Z2 : P_Z1))) + r * 1024;
      s[q] = 0.f;
      _Pragma("unroll") for (int k = 0; k < 4; ++k) {
        float4 a = *(const float4*)(Z + k * 256 + lane * 4);
        if (samp) { _Pragma("unroll") for (int sp = 1; sp < 4; ++sp) { const float4 b = *(const float4*)(Z + (size_t)sp * 512 * 1024 + k * 256 + lane * 4);
          a.x += b.x; a.y += b.y; a.z += b.z; a.w += b.w; } }
        v[q][k] = a; s[q] += a.x + a.y + a.z + a.w; }
    }
    _Pragma("unroll") for (int q = 0; q < 2; ++q) {
      const int row = row0 + q; const int samp = row >= MP; const long r = samp ? row - MP : row;
      const float mu = wave_sum(s[q]) * (1.f / 1024);
      float qq = 0.f;
      _Pragma("unroll") for (int k = 0; k < 4; ++k) { float a = v[q][k].x - mu, b = v[q][k].y - mu, c = v[q][k].z - mu, d = v[q][k].w - mu; qq += a * a + b * b + c * c + d * d; }
      const float rstd = rsqrtf(wave_sum(qq) * (1.f / 1024) + 1e-5f);
      bfu* X = (bfu*)(p.ws + (samp ? OFF_XS : OFF_X)) + r * 1024;
      float* O = p.out + (samp ? O_YS : O_YP) + r * 1024;
      _Pragma("unroll") for (int k = 0; k < 4; ++k) {
        const int c = k * 256 + lane * 4;
        const float4 gg = *(const float4*)(g + c), bb = *(const float4*)(bta + c);
        const float o0 = (v[q][k].x - mu) * rstd * gg.x + bb.x, o1 = (v[q][k].y - mu) * rstd * gg.y + bb.y;
        const float o2 = (v[q][k].z - mu) * rstd * gg.z + bb.z, o3 = (v[q][k].w - mu) * rstd * gg.w + bb.w;
        if (final_) *(float4*)(O + c) = make_float4(o0, o1, o2, o3);
        else *(uint2*)(X + c) = make_uint2(pack2(o0, o1), pack2(o2, o3));
      }
    }
  }
}

DI void mla_prep_unit(const Params& pin, int layer, int samp, int unit) {
  const Params p = relaunder(pin);
  const int tidw = ltid(p); const int wave = tidw >> 6, lane = tidw & 63;
  const int T = samp ? TS : SP;
  const bfu* KVL = (const bfu*)(p.ws + (samp ? S_KVL : P_KVL));
  const float2* tab = (const float2*)(p.ws + OFF_TAB);
  const float g0 = p.in[I_KVG][layer * 128 + 2 * lane], g1 = p.in[I_KVG][layer * 128 + 2 * lane + 1];
  unsigned prv[8];
  _Pragma("unroll") for (int i = 0; i < 8; ++i) prv[i] = *(const unsigned*)(KVL + (long)(unit * 64 + i * 8 + wave) * 160 + lane * 2);
  _Pragma("unroll") for (int i = 0; i < 8; ++i) {
    const int r = unit * 64 + i * 8 + wave; const int b = r / T, t = r % T;
    const unsigned pr = prv[i];
    float x0 = bf2f(pr & 0xffff), x1 = bf2f(pr >> 16);
    float ss = wave_sum(x0 * x0 + x1 * x1);
    float inv = rsqrtf(ss * (1.f / 128) + 1e-6f);
    float c0 = x0 * inv * g0, c1 = x1 * inv * g1;
    if (!samp) {
      *(float2*)(p.out + O_CKVP + ((size_t)(layer * 8 + b) * SP + t) * 128 + 2 * lane) = make_float2(c0, c1);
    } else {
      *(float2*)(p.out + O_CKVS + ((size_t)(layer * 16 + b) * TS + t) * 128 + 2 * lane) = make_float2(c0, c1);
      bfu* KC = (bfu*)(p.ws + S_KCAT); bfu* VT = (bfu*)(p.ws + S_VT);
      *(unsigned*)(KC + ((long)b * SKP + 4096 + t) * 160 + 2 * lane) = pack2(c0, c1);
      VT[((long)b * 128 + 2 * lane) * SKP + 4096 + t] = f2bf(c0);
      VT[((long)b * 128 + 2 * lane + 1) * SKP + 4096 + t] = f2bf(c1);
    }
    if (lane < 16) {
      float xa = bf2f(KVL[(long)r * 160 + 128 + lane]), xb = bf2f(KVL[(long)r * 160 + 144 + lane]);
      const int pos = t + (samp ? 4096 : 0);
      float2 cs = tab[pos * 16 + lane];
      float o1 = xa * cs.x - xb * cs.y, o2 = xb * cs.x + xa * cs.y;
      if (!samp) {
        float* o = p.out + O_KRP + ((size_t)(layer * 8 + b) * SP + t) * 32; o[lane] = o1; o[lane + 16] = o2;
        bfu* KB = (bfu*)(p.ws + P_KB);
        for (int h = 0; h < 6; ++h) { bfu* kr = KB + ((long)(b * 6 + h) * SP + t) * 96 + 64; kr[lane] = f2bf(o1); kr[lane + 16] = f2bf(o2); }
      } else {
        float* o = p.out + O_KRS + ((size_t)(layer * 16 + b) * TS + t) * 32; o[lane] = o1; o[lane + 16] = o2;
        bfu* kr = (bfu*)(p.ws + S_KCAT) + ((long)b * SKP + 4096 + t) * 160 + 128; kr[lane] = f2bf(o1); kr[lane + 16] = f2bf(o2);
      }
    }
  }
}

DI void cache_conv_unit(const Params& pin, int layer, int unit, char* shm) {
  const Params p = relaunder(pin);
  const int tid = ltid(p), b = unit >> 6, t0 = (unit & 63) * 64;
  const float* ck = p.in[I_CCKV] + ((size_t)(layer * 16 + b) * 4096 + t0) * 128;
  const float* kr = p.in[I_CKR] + ((size_t)(layer * 16 + b) * 4096 + t0) * 32;
  bfu* KC = (bfu*)(p.ws + S_KCAT) + ((long)b * SKP + t0) * 160; bfu* VT = (bfu*)(p.ws + S_VT) + (long)b * 128 * SKP + t0;
  bfu* tl = (bfu*)shm;
  _Pragma("unroll") for (int i = 0; i < 4; ++i) { int e = tid + i * NT, tok = e >> 5, c4 = (e & 31) * 4;
    float4 v = *(const float4*)(ck + tok * 128 + c4);
    *(uint2*)(KC + (long)tok * 160 + c4) = make_uint2(pack2(v.x, v.y), pack2(v.z, v.w));
    tl[(c4 + 0) * 72 + tok] = f2bf(v.x); tl[(c4 + 1) * 72 + tok] = f2bf(v.y); tl[(c4 + 2) * 72 + tok] = f2bf(v.z); tl[(c4 + 3) * 72 + tok] = f2bf(v.w); }
  _Pragma("unroll") for (int i = 0; i < 4; ++i) { int e = tid + i * NT, tok = e >> 5, c = e & 31; KC[(long)tok * 160 + 128 + c] = f2bf(kr[tok * 32 + c]); }
  __syncthreads();
  _Pragma("unroll") for (int i = 0; i < 2; ++i) { int e = tid + i * NT, c = e >> 3, part = e & 7;
    *(uint4*)(VT + (long)c * SKP + part * 8) = *(const uint4*)(tl + c * 72 + part * 8); }
  __syncthreads();
}

DI void rwkv_prep_unit(const Params& pin, int layer, int samp, int unit, char* shm) {
  const Params p = relaunder(pin);
  const int tid = ltid(p), wave = tid >> 6, lane = tid & 63;
  const int T = samp ? TS : SP; const int r0 = unit * 32, b = r0 / T, t0 = r0 % T;
  const bfu* PR = (const bfu*)(p.ws + (samp ? S_PR : P_PR));
  const float* mu = p.in[I_MU] + layer * 1280;
  const float* sh0 = samp ? p.in[I_SSH] + (size_t)(layer * 16 + b) * 1280 : nullptr;
  bfu* lorb = (bfu*)shm;
  bfu* prt = (bfu*)(shm + 16384);
  for (int e = tid; e < 4096; e += NT) {
    const int tk = e >> 7, c = e & 127, col = 1152 + c;
    const float cur = bf2f(PR[(long)(r0 + tk) * 1280 + col]);
    const float prev = (t0 + tk == 0) ? (sh0 ? sh0[col] : 0.f) : bf2f(PR[(long)(r0 + tk - 1) * 1280 + col]);
    const float ps = cur + (prev - cur) * mu[col];
    lorb[tk * 136 + c] = f2bf((c < 32) ? tanhf_(ps) : (c < 64 ? ps : sigmoidf_(ps)));
  }
  for (int e = tid; e < 33 * 144; e += NT) {
    const int row = e / 144, c8 = e - row * 144;
    if (row > 0 || t0 > 0) *(uint4*)(prt + row * 1152 + c8 * 8) = *(const uint4*)(PR + (long)(r0 - 1 + row) * 1280 + c8 * 8);
  }
  __syncthreads();
  if (wave < 6) {
    const int h = wave, n16 = lane & 15, kg = lane >> 4;
    const bfu* WL = (const bfu*)(p.ws + layer * LW_STRIDE + LW_LORA);
    f32x4 aW[2][4], aA[2][4], aG[2][4];
    {
      bf16x8 Af[2][4];
      _Pragma("unroll") for (int mt = 0; mt < 2; ++mt) _Pragma("unroll") for (int s = 0; s < 4; ++s)
        Af[mt][s] = *(const bf16x8*)(lorb + (mt * 16 + n16) * 136 + 32 * s + 8 * kg);
      _Pragma("unroll") for (int nt = 0; nt < 4; ++nt) {
        const bfu* wrow = WL + (long)(h * 64 + nt * 16 + n16) * 128 + 8 * kg;
        const bf16x8 B0 = *(const bf16x8*)(wrow), B1 = *(const bf16x8*)(wrow + 32), B2 = *(const bf16x8*)(wrow + 64), B3 = *(const bf16x8*)(wrow + 96);
        _Pragma("unroll") for (int mt = 0; mt < 2; ++mt) {
          const f32x4 z = {0.f, 0.f, 0.f, 0.f};
          aW[mt][nt] = __builtin_amdgcn_mfma_f32_16x16x32_bf16(Af[mt][0], B0, z, 0, 0, 0);
          aA[mt][nt] = __builtin_amdgcn_mfma_f32_16x16x32_bf16(Af[mt][1], B1, z, 0, 0, 0);
          aG[mt][nt] = __builtin_amdgcn_mfma_f32_16x16x32_bf16(Af[mt][2], B2, z, 0, 0, 0);
          aG[mt][nt] = __builtin_amdgcn_mfma_f32_16x16x32_bf16(Af[mt][3], B3, aG[mt][nt], 0, 0, 0);
        }
      }
    }
    bfu* RW = (bfu*)(p.ws + (samp ? S_RW : P_RW)); bfu* G = (bfu*)(p.ws + (samp ? S_G : P_G)); float* BON = (float*)(p.ws + (samp ? S_BON : P_BON));
    float w0[4], a0[4], kkc[4], kac[4], rkc[4], mur[4], muk[4], muv[4];
    _Pragma("unroll") for (int nt = 0; nt < 4; ++nt) { const int c = h * 64 + nt * 16 + n16;
      w0[nt] = p.in[I_W0][layer * 384 + c]; a0[nt] = p.in[I_A0][layer * 384 + c]; kkc[nt] = p.in[I_KK][layer * 384 + c];
      kac[nt] = p.in[I_KA][layer * 384 + c]; rkc[nt] = p.in[I_RK][layer * 384 + c];
      mur[nt] = mu[c]; muk[nt] = mu[384 + c]; muv[nt] = mu[768 + c]; }
    _Pragma("unroll") for (int mt = 0; mt < 2; ++mt) _Pragma("unroll") for (int r = 0; r < 4; ++r) {
      const int tk = mt * 16 + kg * 4 + r;
      const bool usesh = (t0 + tk == 0);
      float rr[4], k2[4], kk[4], vv[4], dd[4], aa[4];
      float n2 = 0.f, bon = 0.f;
      _Pragma("unroll") for (int nt = 0; nt < 4; ++nt) {
        const int c = h * 64 + nt * 16 + n16;
        const bfu* qc = prt + (tk + 1) * 1152, *qp = prt + tk * 1152;
        const float cr = bf2f(qc[c]), ck = bf2f(qc[384 + c]), cv = bf2f(qc[768 + c]);
        const float pr_ = usesh ? (sh0 ? sh0[c] : 0.f) : bf2f(qp[c]);
        const float pk_ = usesh ? (sh0 ? sh0[384 + c] : 0.f) : bf2f(qp[384 + c]);
        const float pv_ = usesh ? (sh0 ? sh0[768 + c] : 0.f) : bf2f(qp[768 + c]);
        const float rv = cr + (pr_ - cr) * mur[nt], kv = ck + (pk_ - ck) * muk[nt]; vv[nt] = cv + (pv_ - cv) * muv[nt];
        const float z = -(w0[nt] + aW[mt][nt][r]);
        const float sp = fmaxf(z, 0.f) + __logf(1.f + __expf(-fabsf(z)));
        const float e = __expf(-sp - 0.5f);
        dd[nt] = 1.f - __expf(-e);
        const float a = sigmoidf_(a0[nt] + aA[mt][nt][r]);
        aa[nt] = a;
        const float kkr = kv * kkc[nt];
        kk[nt] = kkr; n2 += kkr * kkr;
        k2[nt] = kv * (1.f + (a - 1.f) * kac[nt]);
        rr[nt] = rv; bon += rv * k2[nt] * rkc[nt];
      }
      n2 = allred16(n2); bon = allred16(bon);
      const float inv = __builtin_amdgcn_rsqf(fmaxf(n2, 1e-24f));
      const long tok = (long)(b * 6 + h) * T + t0 + tk;
      bfu* o = RW + tok * 384;
      _Pragma("unroll") for (int nt = 0; nt < 4; ++nt) {
        const int j = nt * 16 + n16; const float kkn = kk[nt] * inv;
        o[j] = f2bf(dd[nt]); o[64 + j] = f2bf(k2[nt]); o[128 + j] = f2bf(kkn); o[192 + j] = f2bf(-kkn * aa[nt]); o[256 + j] = f2bf(rr[nt]); o[320 + j] = f2bf(vv[nt]);
        G[(long)(r0 + tk) * 384 + h * 64 + j] = f2bf(aG[mt][nt][r]);
      }
      if (n16 == 0) BON[(long)(r0 + tk) * 6 + h] = bon;
    }
  }
  __syncthreads();
}

constexpr int PSTR = 720;
constexpr int SCAN_DBUF = 16 * PSTR * 4;
struct ScanRegs { unsigned short a[4][12]; };
DI void scan_ld(ScanRegs& R, const bfu* RW, int chunk, int pg, int j) {
  _Pragma("unroll") for (int q = 0; q < 4; ++q) _Pragma("unroll") for (int sv = 0; sv < 12; ++sv)
    R.a[q][sv] = RW[((long)chunk * 32 + (pg * 4 + q) * 2 + sv / 6) * 384 + (sv % 6) * 64 + j];
}
DI void scan_derive(const ScanRegs& R, float* D, int pg, int j) {
  _Pragma("unroll") for (int q = 0; q < 4; ++q) {
    float* o = D + (pg * 4 + q) * PSTR;
    const float d1 = bf2f(R.a[q][0]), k1 = bf2f(R.a[q][1]), kk1 = bf2f(R.a[q][2]), ka1 = bf2f(R.a[q][3]), r1 = bf2f(R.a[q][4]), v1 = bf2f(R.a[q][5]);
    const float d2 = bf2f(R.a[q][6]), k2 = bf2f(R.a[q][7]), kk2 = bf2f(R.a[q][8]), ka2 = bf2f(R.a[q][9]), r2 = bf2f(R.a[q][10]), v2 = bf2f(R.a[q][11]);
    const float w1 = 1.f - d1, w2 = 1.f - d2, w12 = w1 * w2, ka1w2 = ka1 * w2, k1w2 = k1 * w2;
    o[j] = kk1; o[64 + j] = w1 * kk2; o[128 + j] = w1 * r1; o[192 + j] = w12 * r2; o[256 + j] = w12; o[320 + j] = ka1w2; o[384 + j] = k1w2;
    o[448 + j] = ka2; o[512 + j] = k2; o[576 + j] = v1; o[640 + j] = v2;
    const float c1 = wave_sum(ka1 * kk2), c2 = wave_sum(k1 * kk2), c3 = wave_sum(ka1 * r1), c4 = wave_sum(k1 * r1);
    const float c5 = wave_sum(ka1w2 * r2), c6 = wave_sum(k1w2 * r2), c7 = wave_sum(ka2 * r2), c8 = wave_sum(k2 * r2);
    if (j == 0) { *(float4*)(o + 704) = make_float4(c1, c2, c3, c4); *(float4*)(o + 708) = make_float4(c5, c6, c7, c8); }
  }
}
DI void scan_drain(const float* yb, bfu* Y, int chunk, int half, int ptid) {
  const int s = ptid >> 3, r4 = (ptid & 7) * 4;
  const float4 v = *(const float4*)(yb + s * 32 + r4);
  *(uint2*)(Y + (long)(chunk * 32 + s) * 384 + half * 32 + r4) = make_uint2(pack2(v.x, v.y), pack2(v.z, v.w));
}
typedef float f2 __attribute__((ext_vector_type(2)));
DI f2 lo2(const float4& a) { return f2{a.x, a.y}; }
DI f2 hi2(const float4& a) { return f2{a.z, a.w}; }
DI float dot4v(const f2 slo, const f2 shi, const float4& a) { const f2 t = slo * lo2(a) + shi * hi2(a); return t.x + t.y; }
DI void allred16x8(float& x0, float& x1, float& x2, float& x3, float& x4, float& x5, float& x6, float& x7) {
#define DPPSTAGE(N) \
  "v_add_f32_dpp %0, %0, %0 row_ror:" #N " row_mask:0xf bank_mask:0xf\n\t" \
  "v_add_f32_dpp %1, %1, %1 row_ror:" #N " row_mask:0xf bank_mask:0xf\n\t" \
  "v_add_f32_dpp %2, %2, %2 row_ror:" #N " row_mask:0xf bank_mask:0xf\n\t" \
  "v_add_f32_dpp %3, %3, %3 row_ror:" #N " row_mask:0xf bank_mask:0xf\n\t" \
  "v_add_f32_dpp %4, %4, %4 row_ror:" #N " row_mask:0xf bank_mask:0xf\n\t" \
  "v_add_f32_dpp %5, %5, %5 row_ror:" #N " row_mask:0xf bank_mask:0xf\n\t" \
  "v_add_f32_dpp %6, %6, %6 row_ror:" #N " row_mask:0xf bank_mask:0xf\n\t" \
  "v_add_f32_dpp %7, %7, %7 row_ror:" #N " row_mask:0xf bank_mask:0xf\n\t"
  asm volatile("s_nop 1\n\t" DPPSTAGE(8) DPPSTAGE(4) DPPSTAGE(2) DPPSTAGE(1)
               : "+v"(x0), "+v"(x1), "+v"(x2), "+v"(x3), "+v"(x4), "+v"(x5), "+v"(x6), "+v"(x7));
#undef DPPSTAGE
}
DI void rwkv_scan_unit(const Params& pin, int layer, int samp, int unit, char* shm) {
  const Params p = relaunder(pin);
  const int tid = ltid(p), wave = tid >> 6, lane = tid & 63, rg = lane >> 4, cgi = lane & 15;
  const int T = samp ? TS : SP; const int half = unit & 1, bh = unit >> 1; const int b = bh / 6, h = bh % 6;
  const bool act = wave < 4;
  const int ptid = tid & 255, pg = (wave & 3);
  const int lrow = (wave & 3) * 8 + rg * 2, row0 = half * 32 + lrow, col0 = cgi * 4;
  const bfu* RW = (const bfu*)(p.ws + (samp ? S_RW : P_RW)) + (long)bh * T * 384;
  bfu* Y = (bfu*)(p.ws + (samp ? S_Y : P_Y)) + (long)b * T * 384 + h * 64;
  float* ybuf = (float*)(shm + 2 * SCAN_DBUF);
  const int nch = T / 32;
  f2 Slo[2], Shi[2];
  ScanRegs R;
  if (act) {
    if (samp) { const float* s0 = p.in[I_SRW] + ((size_t)(layer * 16 + b) * 6 + h) * 4096;
      _Pragma("unroll") for (int rr = 0; rr < 2; ++rr) { float4 v = *(const float4*)(s0 + (row0 + rr) * 64 + col0); Slo[rr] = f2{v.x, v.y}; Shi[rr] = f2{v.z, v.w}; } }
    else { _Pragma("unroll") for (int rr = 0; rr < 2; ++rr) { Slo[rr] = f2{0.f, 0.f}; Shi[rr] = f2{0.f, 0.f}; } }
  } else {
    Slo[0] = Slo[1] = Shi[0] = Shi[1] = f2{0.f, 0.f};
    scan_ld(R, RW, 0, pg, lane); scan_derive(R, (float*)shm, pg, lane);
    if (1 < nch) scan_ld(R, RW, 1, pg, lane);
  }
  __syncthreads();
  for (int ch = 0; ch < nch; ++ch) {
    if (act) {
      const float* D = (const float*)(shm + (ch & 1) * SCAN_DBUF);
      float* yb = ybuf + (ch & 1) * 1024;
      for (int q = 0; q < 16; ++q) {
        const float* o = D + q * PSTR;
        const float4 kk1 = *(const float4*)(o + col0), w1k2 = *(const float4*)(o + 64 + col0), w1r1 = *(const float4*)(o + 128 + col0),
                     w12r2 = *(const float4*)(o + 192 + col0), w12 = *(const float4*)(o + 256 + col0), ka1w2 = *(const float4*)(o + 320 + col0),
                     k1w2 = *(const float4*)(o + 384 + col0), ka2 = *(const float4*)(o + 448 + col0), k2 = *(const float4*)(o + 512 + col0);
        const float2 v1 = *(const float2*)(o + 576 + row0), v2 = *(const float2*)(o + 640 + row0);
        const float4 ca = *(const float4*)(o + 704), cb = *(const float4*)(o + 708);
        float pa[2], pb[2], pc[2], pd[2];
        _Pragma("unroll") for (int rr = 0; rr < 2; ++rr) {
          pa[rr] = dot4v(Slo[rr], Shi[rr], kk1); pb[rr] = dot4v(Slo[rr], Shi[rr], w1k2);
          pc[rr] = dot4v(Slo[rr], Shi[rr], w1r1); pd[rr] = dot4v(Slo[rr], Shi[rr], w12r2); }
        allred16x8(pa[0], pa[1], pb[0], pb[1], pc[0], pc[1], pd[0], pd[1]);
        float y1[2], y2[2];
        _Pragma("unroll") for (int rr = 0; rr < 2; ++rr) {
          const float vv1 = rr ? v1.y : v1.x, vv2 = rr ? v2.y : v2.x;
          const float a1 = pa[rr];
          const float a2 = pb[rr] + a1 * ca.x + vv1 * ca.y;
          y1[rr] = pc[rr] + a1 * ca.z + vv1 * ca.w;
          y2[rr] = pd[rr] + a1 * cb.x + vv1 * cb.y + a2 * cb.z + vv2 * cb.w;
          Slo[rr] = Slo[rr] * lo2(w12) + a1 * lo2(ka1w2) + vv1 * lo2(k1w2) + a2 * lo2(ka2) + vv2 * lo2(k2);
          Shi[rr] = Shi[rr] * hi2(w12) + a1 * hi2(ka1w2) + vv1 * hi2(k1w2) + a2 * hi2(ka2) + vv2 * hi2(k2);
        }
        if (cgi == 0) { *(float2*)(yb + (2 * q) * 32 + lrow) = make_float2(y1[0], y1[1]); *(float2*)(yb + (2 * q + 1) * 32 + lrow) = make_float2(y2[0], y2[1]); }
      }
    } else {
      if (ch + 1 < nch) scan_derive(R, (float*)(shm + ((ch + 1) & 1) * SCAN_DBUF), pg, lane);
      if (ch + 2 < nch) scan_ld(R, RW, ch + 2, pg, lane);
      if (ch >= 1) scan_drain(ybuf + ((ch - 1) & 1) * 1024, Y, ch - 1, half, ptid);
    }
    __syncthreads();
  }
  if (!act) scan_drain(ybuf + ((nch - 1) & 1) * 1024, Y, nch - 1, half, ptid);
  if (act) {
    float* so = p.out + (samp ? O_RWS : O_RWP) + ((size_t)(layer * (samp ? 16 : 8) + b) * 6 + h) * 4096;
    _Pragma("unroll") for (int rr = 0; rr < 2; ++rr) *(float4*)(so + (row0 + rr) * 64 + col0) = make_float4(Slo[rr].x, Slo[rr].y, Shi[rr].x, Shi[rr].y);
  }
  __syncthreads();
}

constexpr size_t OFF_S5E = OFF_CTL + 65536;
constexpr int S5_NSEG = 8, S5_LSEG = SP / S5_NSEG;
DI void s5_unit(const Params& pin, int layer, int samp, int unit, int mode, char* shm) {
  const Params p = relaunder(pin);
  const int tid = ltid(p), wave = tid >> 6, lane = tid & 63;
  const int T = samp ? TS : SP;
  const int seg = samp ? 0 : (unit & 7); const int ub = samp ? unit : (unit >> 3);
  const int b = ub >> 1, g = (ub & 1) * 8 + wave;
  const int tbeg = samp ? 0 : seg * S5_LSEG, tend = samp ? TS : tbeg + S5_LSEG;
  float2* Eb = (float2*)(p.ws + OFF_S5E) + ((size_t)(b * 16 + g) * S5_NSEG) * 64 + lane;
  const int gp = (layer * 16 + g) * 64 + lane;
  const float lre = p.in[I_LRE][gp], lim = p.in[I_LIM][gp];
  const float dt = expf(p.in[I_LDT][layer * 16 + g]);
  const float ang = lim * dt;
  const float sn = sinf(ang), cs = cosf(ang);
  const float mag = expf(lre * dt);
  const float lr = mag * cs, li = mag * sn;
  const float nr = lr - 1.f, ni = li, den = lre * lre + lim * lim;
  const float cr_ = (nr * lre + ni * lim) / den, ci_ = (ni * lre - nr * lim) / den;
  float Br[16], Bi[16];
  { const float* bre = p.in[I_BRE] + (size_t)gp * 16, *bim = p.in[I_BIM] + (size_t)gp * 16;
    _Pragma("unroll") for (int c = 0; c < 16; ++c) { const float br = bre[c], bi = bim[c]; Br[c] = cr_ * br - ci_ * bi; Bi[c] = cr_ * bi + ci_ * br; } }
  bf16x8 Cf[4];
  { const int n = lane & 15, kg = lane >> 4;
    const float* cre = p.in[I_CRE] + ((size_t)(layer * 16 + g) * 16 + n) * 64, *cim = p.in[I_CIM] + ((size_t)(layer * 16 + g) * 16 + n) * 64;
    _Pragma("unroll") for (int s = 0; s < 4; ++s) _Pragma("unroll") for (int j = 0; j < 8; ++j) { int k = 32 * s + 8 * kg + j;
      float v = (k < 64) ? cre[k] : -cim[k - 64]; Cf[s][j] = (short)f2bf(v); } }
  const float Dd = p.in[I_S5D][layer * 256 + g * 16 + (lane & 15)];
  float xr = 0.f, xi = 0.f;
  if (samp) { const float* s0 = p.in[I_SS5] + ((size_t)(layer * 16 + b) * 16 + g) * 128 + lane * 2; xr = s0[0]; xi = s0[1]; }
  else if (mode == 2 && seg > 0) {
    const float magL = expf((float)S5_LSEG * lre * dt);
    const float angr = ang - 6.283185307179586f * rintf(ang * 0.15915494309189535f);
    const float angL = (float)S5_LSEG * angr;
    const float Lr = magL * cosf(angL), Li = magL * sinf(angL);
    for (int s2 = 0; s2 < seg; ++s2) { const float2 ev = Eb[s2 * 64];
      const float nr_ = Lr * xr - Li * xi + ev.x, ni_ = Lr * xi + Li * xr + ev.y; xr = nr_; xi = ni_; }
  }
  char* wsm = shm + wave * 6144;
  float* ut = (float*)wsm; bfu* xt = (bfu*)(wsm + 1024);
  const bfu* U = (const bfu*)(p.ws + (samp ? S_U : P_U)) + (long)b * T * 256 + g * 16;
  bfu* ZO = (bfu*)(p.ws + (samp ? S_ZS5 : P_ZS5)) + (long)b * T * 256 + g * 16;
  uint4 un = make_uint4(0, 0, 0, 0);
  if (lane < 32) un = *(const uint4*)(U + (long)(tbeg + (lane >> 1)) * 256 + (lane & 1) * 8);
  for (int t0 = tbeg; t0 < tend; t0 += 16) {
    if (lane < 32) { const unsigned w[4] = {un.x, un.y, un.z, un.w}; float* d = ut + (lane >> 1) * 16 + (lane & 1) * 8;
      *(float4*)d = make_float4(bf2f(w[0] & 0xffff), bf2f(w[0] >> 16), bf2f(w[1] & 0xffff), bf2f(w[1] >> 16));
      *(float4*)(d + 4) = make_float4(bf2f(w[2] & 0xffff), bf2f(w[2] >> 16), bf2f(w[3] & 0xffff), bf2f(w[3] >> 16)); }
    if (t0 + 16 < tend && lane < 32) un = *(const uint4*)(U + (long)(t0 + 16 + (lane >> 1)) * 256 + (lane & 1) * 8);
    __builtin_amdgcn_fence(__ATOMIC_RELEASE, "wavefront"); __builtin_amdgcn_wave_barrier(); __builtin_amdgcn_fence(__ATOMIC_ACQUIRE, "wavefront");
    for (int tt = 0; tt < 16; ++tt) {
      const float4* up = (const float4*)(ut + tt * 16);
      const float4 u0 = up[0], u1 = up[1], u2 = up[2], u3 = up[3];
      const float u[16] = {u0.x, u0.y, u0.z, u0.w, u1.x, u1.y, u1.z, u1.w, u2.x, u2.y, u2.z, u2.w, u3.x, u3.y, u3.z, u3.w};
      float br = 0.f, bi = 0.f;
      _Pragma("unroll") for (int c = 0; c < 16; ++c) { br += Br[c] * u[c]; bi += Bi[c] * u[c]; }
      const float nxr = lr * xr - li * xi + br, nxi = lr * xi + li * xr + bi;
      xr = nxr; xi = nxi;
      if (mode == 2) { xt[tt * 136 + lane] = f2bf(xr); xt[tt * 136 + 64 + lane] = f2bf(xi); }
    }
    if (mode == 2) {
    __builtin_amdgcn_fence(__ATOMIC_RELEASE, "wavefront"); __builtin_amdgcn_wave_barrier(); __builtin_amdgcn_fence(__ATOMIC_ACQUIRE, "wavefront");
    f32x4 acc = {0.f, 0.f, 0.f, 0.f};
    { const int row = lane & 15, kg = lane >> 4;
      _Pragma("unroll") for (int s = 0; s < 4; ++s) { bf16x8 a = *(const bf16x8*)(xt + row * 136 + 32 * s + 8 * kg);
        acc = __builtin_amdgcn_mfma_f32_16x16x32_bf16(a, Cf[s], acc, 0, 0, 0); } }
    { const int ch = lane & 15, tq = lane >> 4;
      _Pragma("unroll") for (int r = 0; r < 4; ++r) { const int tk = tq * 4 + r;
        float y = acc[r] + Dd * ut[tk * 16 + ch];
        float z = 0.5f * y * (1.f + tanhf_(0.7978845608028654f * (y + 0.044715f * y * y * y)));
        ZO[(long)(t0 + tk) * 256 + ch] = f2bf(z); } }
    }
    __builtin_amdgcn_fence(__ATOMIC_RELEASE, "wavefront"); __builtin_amdgcn_wave_barrier(); __builtin_amdgcn_fence(__ATOMIC_ACQUIRE, "wavefront");
  }
  if (mode == 1) { Eb[seg * 64] = make_float2(xr, xi); }
  else if (samp || seg == S5_NSEG - 1) {
    float* so = p.out + (samp ? O_S5S : O_S5P) + ((size_t)(layer * (samp ? 16 : 8) + b) * 16 + g) * 128 + lane * 2;
    so[0] = xr; so[1] = xi; }
}

template <int DQK, int DV>
struct Attn {
  static constexpr int PK = DQK * 2 + 16, PV = 144;
  static constexpr int KT_BYTES = 64 * PK, VT_BYTES = DV * PV, BUF = KT_BYTES + VT_BYTES;
  static constexpr int NCK = 64 * DQK / 8, NCV = DV * 8, NC = NCK + NCV, NLD = (NC + NT - 1) / NT;
  static_assert(NLD <= 5, "NLD");
  static constexpr int NS = DQK / 16, NMT = DV / 32;
  static_assert(2 * BUF + 49152 <= SHM_MAIN, "attn LDS");


  struct St { uint4 a0, a1, a2, a3, a4; };
  template <int I> static DI void g1(uint4& s, const bfu* Kbase, const bfu* Vtbase, long Tstride, int tile, const int tid) {
    if constexpr (I < NLD) { const int c = tid + I * NT;
      if (c < NCK) s = *(const uint4*)(Kbase + (long)tile * 64 * DQK + (long)c * 8);
      else if (c < NC) { const int cv = c - NCK, d = cv >> 3, part = cv & 7; s = *(const uint4*)(Vtbase + (long)d * Tstride + (long)tile * 64 + part * 8); } }
  }
  template <int I> static DI void s1(const uint4& s, char* base, const int tid) {
    if constexpr (I < NLD) { const int c = tid + I * NT;
      if (c < NCK) { const int row = c / (DQK / 8), col = c % (DQK / 8); *(uint4*)(base + row * PK + col * 16) = s; }
      else if (c < NC) { const int cv = c - NCK, d = cv >> 3, part = cv & 7; *(uint4*)(base + KT_BYTES + d * PV + part * 16) = s; } }
  }
  static DI void gload(St& st, const bfu* Kbase, const bfu* Vtbase, long Tstride, int tile, const int tid) {
    g1<0>(st.a0, Kbase, Vtbase, Tstride, tile, tid); g1<1>(st.a1, Kbase, Vtbase, Tstride, tile, tid); g1<2>(st.a2, Kbase, Vtbase, Tstride, tile, tid);
    g1<3>(st.a3, Kbase, Vtbase, Tstride, tile, tid); g1<4>(st.a4, Kbase, Vtbase, Tstride, tile, tid);
  }
  static DI void lstore(const St& st, char* shm, int buf, const int tid) {
    char* base = shm + buf * BUF;
    s1<0>(st.a0, base, tid); s1<1>(st.a1, base, tid); s1<2>(st.a2, base, tid); s1<3>(st.a3, base, tid); s1<4>(st.a4, base, tid);
  }
  static DI float xmax32(float x) {
    const unsigned u = __float_as_uint(x);
    auto r = __builtin_amdgcn_permlane32_swap(u, u, false, false);
    return fmaxf(__uint_as_float(r[0]), __uint_as_float(r[1]));
  }
  static DI float xsum32(float x) {
    const unsigned u = __float_as_uint(x);
    auto r = __builtin_amdgcn_permlane32_swap(u, u, false, false);
    return __uint_as_float(r[0]) + __uint_as_float(r[1]);
  }
  static DI float softmax32(f32x16& s, const int keybase, const int key_limit, const bool domask, const bool force, f32x16 (&O)[NMT], f32x16& negm,
                           float& mrun, float& l, const int hh, bf16x8 (&pf)[2]) {
    if (domask) { _Pragma("unroll") for (int r = 0; r < 16; ++r) { const int key = keybase + crow(r, hh); if (key >= key_limit) s[r] = -1e30f; } }
    float mx = fmaxf(s[0], s[1]);
    _Pragma("unroll") for (int r = 2; r < 16; ++r) mx = fmaxf(mx, s[r]);
    mx = xmax32(mx);
    float shift = 0.f;
    if (mx > 6.f || force) {
      shift = mx;
      mrun += mx;
      if (!force) {
        const float corr = __builtin_amdgcn_exp2f(-mx);
        l *= corr;
        _Pragma("unroll") for (int mt = 0; mt < NMT; ++mt) _Pragma("unroll") for (int r = 0; r < 16; ++r) O[mt][r] *= corr;
      }
      _Pragma("unroll") for (int r = 0; r < 16; ++r) { s[r] -= mx; negm[r] = -mrun; }
    }
    _Pragma("unroll") for (int r = 0; r < 16; ++r) { const float pv = __builtin_amdgcn_exp2f(s[r]); l += pv; s[r] = pv; }
    _Pragma("unroll") for (int sp = 0; sp < 2; ++sp) _Pragma("unroll") for (int j = 0; j < 8; ++j) pf[sp][j] = (short)f2bf(s[8 * sp + j]);
    return shift;
  }
  static DI void pv32(const char* vb, const int k2, const bf16x8 (&pf)[2], f32x16 (&O)[NMT], const int ln, const int hh) {
    _Pragma("unroll") for (int sp = 0; sp < 2; ++sp) _Pragma("unroll") for (int mt = 0; mt < NMT; ++mt) {
      const char* vp = vb + (mt * 32 + ln) * PV + (k2 * 32 + sp * 16 + hh * 4) * 2;
      s16x4 lo = *(const s16x4*)vp, hi = *(const s16x4*)(vp + 16);
      bf16x8 vf = __builtin_shufflevector(lo, hi, 0, 1, 2, 3, 4, 5, 6, 7);
      O[mt] = __builtin_amdgcn_mfma_f32_32x32x16_bf16(vf, pf[sp], O[mt], 0, 0, 0);
    }
  }
  static DI void compute(const char* kb, const int kt, const int key_limit, const bf16x8 (&qf)[NS], f32x16 (&O)[NMT], f32x16& negm,
                         float& mrun, float& l, const int ln, const int hh) {
    const char* vb = kb + KT_BYTES;
    f32x16 s0 = negm, s1 = negm;
    _Pragma("unroll") for (int si = 0; si < NS; ++si) {
      bf16x8 a = *(const bf16x8*)(kb + ln * PK + (si * 16 + hh * 8) * 2);
      s0 = __builtin_amdgcn_mfma_f32_32x32x16_bf16(a, qf[si], s0, 0, 0, 0);
    }
    _Pragma("unroll") for (int si = 0; si < NS; ++si) {
      bf16x8 a = *(const bf16x8*)(kb + (32 + ln) * PK + (si * 16 + hh * 8) * 2);
      s1 = __builtin_amdgcn_mfma_f32_32x32x16_bf16(a, qf[si], s1, 0, 0, 0);
    }
    __builtin_amdgcn_sched_barrier(0);
    const bool domask = (kt + 1) * 64 > key_limit;
    bf16x8 pf[2];
    const float sh0 = softmax32(s0, kt * 64, key_limit, domask, kt == 0, O, negm, mrun, l, hh, pf);
    __builtin_amdgcn_sched_barrier(0);
    pv32(vb, 0, pf, O, ln, hh);
    __builtin_amdgcn_sched_barrier(0);
    bf16x8 pg[2];
    if (sh0 != 0.f) { _Pragma("unroll") for (int r = 0; r < 16; ++r) s1[r] -= sh0; }
    softmax32(s1, kt * 64 + 32, key_limit, domask, false, O, negm, mrun, l, hh, pg);
    __builtin_amdgcn_sched_barrier(0);
    pv32(vb, 1, pg, O, ln, hh);
  }

  static DI void run(const bfu* Kbase, const bfu* Vtbase, long Tstride, int ntiles_unit, int my_ntiles, int key_limit,
                     const bfu* qptr  , char* shm, f32x16 (&O)[NMT], float& lsum, const int tid) {
    const int lane = tid & 63, ln = lane & 31, hh = lane >> 5;
    bf16x8 qf[NS];
    if (my_ntiles > 0) { _Pragma("unroll") for (int s = 0; s < NS; ++s) qf[s] = *(const bf16x8*)(qptr + s * 16 + hh * 8); }
    else { _Pragma("unroll") for (int s = 0; s < NS; ++s) qf[s] = bf16x8{0, 0, 0, 0, 0, 0, 0, 0}; }
    _Pragma("unroll") for (int mt = 0; mt < NMT; ++mt) _Pragma("unroll") for (int r = 0; r < 16; ++r) O[mt][r] = 0.f;
    float mrun = 0.f, l = 0.f;
    f32x16 negm; _Pragma("unroll") for (int r = 0; r < 16; ++r) negm[r] = 0.f;
    St s0, s1;
    s0.a0 = s0.a1 = s0.a2 = s0.a3 = s0.a4 = make_uint4(0, 0, 0, 0); s1 = s0;
    const int n = ntiles_unit;
    gload(s0, Kbase, Vtbase, Tstride, 0, tid); lstore(s0, shm, 0, tid);
    if (1 < n) gload(s0, Kbase, Vtbase, Tstride, 1, tid);
    __syncthreads();
    for (int kt = 0; kt < n; kt += 2) {
      if (kt + 2 < n) gload(s1, Kbase, Vtbase, Tstride, kt + 2, tid);
      if (kt < my_ntiles) compute(shm, kt, key_limit, qf, O, negm, mrun, l, ln, hh);
      if (kt + 1 < n) lstore(s0, shm, 1, tid);
      __syncthreads();
      if (kt + 1 < n) {
        if (kt + 3 < n) gload(s0, Kbase, Vtbase, Tstride, kt + 3, tid);
        if (kt + 1 < my_ntiles) compute(shm + BUF, kt + 1, key_limit, qf, O, negm, mrun, l, ln, hh);
        if (kt + 2 < n) lstore(s1, shm, 0, tid);
        __syncthreads();
      }
    }
    lsum = xsum32(l);
  }
};


struct AttnP {
  static constexpr int DQK = 96, DV = 64;
  static constexpr int PK = DQK * 2 + 16, PV = 144;
  static constexpr int KT_BYTES = 64 * PK, VT_BYTES = DV * PV, BUF = KT_BYTES + VT_BYTES;
  static constexpr int NCK = 64 * DQK / 8, NCV = DV * 8, NC = NCK + NCV;
  static constexpr int NS = DQK / 16, NMT = DV / 32;
  struct St { uint4 a0, a1, a2; };
  template <int I> static DI void g1(uint4& s, const bfu* Kbase, const bfu* Vtbase, long Tstride, int tile, const int tid) {
    const int c = tid + I * NT;
    if (c < NCK) s = *(const uint4*)(Kbase + (long)tile * 64 * DQK + (long)c * 8);
    else if (c < NC) { const int cv = c - NCK, d = cv >> 3, part = cv & 7; s = *(const uint4*)(Vtbase + (long)d * Tstride + (long)tile * 64 + part * 8); }
  }
  template <int I> static DI void s1(const uint4& s, char* base, const int tid) {
    const int c = tid + I * NT;
    if (c < NCK) { const int row = c / (DQK / 8), col = c % (DQK / 8); *(uint4*)(base + row * PK + col * 16) = s; }
    else if (c < NC) { const int cv = c - NCK, d = cv >> 3, part = cv & 7; const int g = part >> 1, a = part & 1;
      char* row = base + KT_BYTES + d * PV + g * 32;
      *(uint2*)(row + 8 * a) = make_uint2(s.x, s.y); *(uint2*)(row + 16 + 8 * a) = make_uint2(s.z, s.w); }
  }
  static DI void gload(St& st, const bfu* Kbase, const bfu* Vtbase, long Tstride, int tile, const int tid) {
    g1<0>(st.a0, Kbase, Vtbase, Tstride, tile, tid); g1<1>(st.a1, Kbase, Vtbase, Tstride, tile, tid); g1<2>(st.a2, Kbase, Vtbase, Tstride, tile, tid);
  }
  static DI void lstore(const St& st, char* base, const int tid) { s1<0>(st.a0, base, tid); s1<1>(st.a1, base, tid); s1<2>(st.a2, base, tid); }
  static DI float xmax32(float x) { const unsigned u = __float_as_uint(x); auto r = __builtin_amdgcn_permlane32_swap(u, u, false, false);
    return fmaxf(__uint_as_float(r[0]), __uint_as_float(r[1])); }
  static DI float xsum32(float x) { const unsigned u = __float_as_uint(x); auto r = __builtin_amdgcn_permlane32_swap(u, u, false, false);
    return __uint_as_float(r[0]) + __uint_as_float(r[1]); }
  static DI void softmax32(f32x16& s, const bool force, f32x16 (&O)[NMT], float& mrun, float& l) {
    float mx = fmaxf(s[0], s[1]);
    _Pragma("unroll") for (int r = 2; r < 16; ++r) mx = fmaxf(mx, s[r]);
    mx = xmax32(mx);
    if (mx > mrun + 6.f || force) {
      if (!force) { const float corr = __builtin_amdgcn_exp2f(mrun - mx); l *= corr;
        _Pragma("unroll") for (int mt = 0; mt < NMT; ++mt) _Pragma("unroll") for (int r = 0; r < 16; ++r) O[mt][r] *= corr; }
      mrun = mx;
    }
    const float m = mrun;
    _Pragma("unroll") for (int r = 0; r < 16; ++r) { const float pv = __builtin_amdgcn_exp2f(s[r] - m); l += pv; s[r] = pv; }
  }
  static DI void compute(const char* kb, const bool first, const bf16x8 (&qa)[NS], const bf16x8 (&qb)[NS], f32x16 (&OA)[NMT], f32x16 (&OB)[NMT],
                         float& mA, float& mB, float& lA, float& lB, const int ln, const int hh) {
    const char* vb = kb + KT_BYTES;
    _Pragma("unroll") for (int k2 = 0; k2 < 2; ++k2) {
      f32x16 sA, sB;
      _Pragma("unroll") for (int r = 0; r < 16; ++r) { sA[r] = 0.f; sB[r] = 0.f; }
      _Pragma("unroll") for (int si = 0; si < NS; ++si) {
        const bf16x8 a = *(const bf16x8*)(kb + (k2 * 32 + ln) * PK + (si * 16 + hh * 8) * 2);
        sA = __builtin_amdgcn_mfma_f32_32x32x16_bf16(a, qa[si], sA, 0, 0, 0);
        sB = __builtin_amdgcn_mfma_f32_32x32x16_bf16(a, qb[si], sB, 0, 0, 0);
      }
      softmax32(sA, first && k2 == 0, OA, mA, lA);
      softmax32(sB, first && k2 == 0, OB, mB, lB);
      _Pragma("unroll") for (int sp = 0; sp < 2; ++sp) {
        bf16x8 pA, pB;
        _Pragma("unroll") for (int j = 0; j < 8; ++j) { pA[j] = (short)f2bf(sA[8 * sp + j]); pB[j] = (short)f2bf(sB[8 * sp + j]); }
        _Pragma("unroll") for (int mt = 0; mt < NMT; ++mt) {
          const bf16x8 vf = *(const bf16x8*)(vb + (mt * 32 + ln) * PV + (k2 * 32 + sp * 16) * 2 + hh * 16);
          OA[mt] = __builtin_amdgcn_mfma_f32_32x32x16_bf16(vf, pA, OA[mt], 0, 0, 0);
          OB[mt] = __builtin_amdgcn_mfma_f32_32x32x16_bf16(vf, pB, OB[mt], 0, 0, 0);
        }
      }
    }
  }
  static DI void run(const bfu* Kbase, const bfu* Vtbase, long Tstride, int ntiles_unit, int my_ntiles, const bfu* qptr, long qstride,
                     char* shm, f32x16 (&OA)[NMT], f32x16 (&OB)[NMT], float& lsA, float& lsB, const int tid) {
    const int lane = tid & 63, ln = lane & 31, hh = lane >> 5;
    bf16x8 qa[NS], qb[NS];
    _Pragma("unroll") for (int s = 0; s < NS; ++s) { qa[s] = *(const bf16x8*)(qptr + s * 16 + hh * 8); qb[s] = *(const bf16x8*)(qptr + 32 * qstride + s * 16 + hh * 8); }
    _Pragma("unroll") for (int mt = 0; mt < NMT; ++mt) _Pragma("unroll") for (int r = 0; r < 16; ++r) { OA[mt][r] = 0.f; OB[mt][r] = 0.f; }
    float mA = 0.f, mB = 0.f, lA = 0.f, lB = 0.f;
    St st; st.a0 = st.a1 = st.a2 = make_uint4(0, 0, 0, 0);
    const int n = ntiles_unit;
    gload(st, Kbase, Vtbase, Tstride, 0, tid); lstore(st, shm, tid);
    if (1 < n) gload(st, Kbase, Vtbase, Tstride, 1, tid);
    __syncthreads();
    for (int kt = 0; kt < n; ++kt) {
      if (kt < my_ntiles) compute(shm + (kt & 1) * BUF, kt == 0, qa, qb, OA, OB, mA, mB, lA, lB, ln, hh);
      if (kt + 1 < n) lstore(st, shm + ((kt + 1) & 1) * BUF, tid);
      if (kt + 2 < n) gload(st, Kbase, Vtbase, Tstride, kt + 2, tid);
      __syncthreads();
    }
    lsA = xsum32(lA); lsB = xsum32(lB);
  }
};

DI void attn_prompt_unit(const Params& pin, const int bh, const int qb, char* shm) {
  const Params p = relaunder(pin);
  const int b = bh / 6, h = bh % 6;
  const int tidu = ltid(p);
  const int wave = tidu >> 6, lane = tidu & 63, ln = lane & 31, hh = lane >> 5;
  const int q0 = qb * 512 + wave * 64;
  const bfu* Kb = (const bfu*)(p.ws + P_KB) + (long)bh * SP * 96;
  const bfu* Vt = (const bfu*)(p.ws + P_VT) + (long)bh * 64 * SP;
  const bfu* Q = (const bfu*)(p.ws + P_Q) + ((long)b * SP + q0 + ln) * 576 + h * 96;
  f32x16 OA[2], OB[2]; float lsA, lsB;
  AttnP::run(Kb, Vt, SP, qb * 8 + 8, q0 / 64 + 1, Q, 576, shm, OA, OB, lsA, lsB, tidu);
  const float invA = 1.f / lsA, invB = 1.f / lsB;
  bfu* MG = (bfu*)(p.ws + P_MERGED) + ((long)b * SP + q0 + ln) * 1024 + h * 64;
  _Pragma("unroll") for (int mt = 0; mt < 2; ++mt) _Pragma("unroll") for (int g = 0; g < 4; ++g) {
    const int d0 = mt * 32 + 8 * g + 4 * hh;
    *(uint2*)(MG + d0) = make_uint2(pack2(OA[mt][4 * g] * invA, OA[mt][4 * g + 1] * invA), pack2(OA[mt][4 * g + 2] * invA, OA[mt][4 * g + 3] * invA));
    *(uint2*)(MG + 32 * 1024 + d0) = make_uint2(pack2(OB[mt][4 * g] * invB, OB[mt][4 * g + 1] * invB), pack2(OB[mt][4 * g + 2] * invB, OB[mt][4 * g + 3] * invB));
  }
}

DI void attn_sample_unit(const Params& pin, int layer, int b, char* shm) {
  const Params p = relaunder(pin);
  const int tid = ltid(p), wave = tid >> 6, lane = tid & 63, ln = lane & 31, hh = lane >> 5;
  const bfu* Qs = (const bfu*)(p.ws + S_Q);
  bfu* QA = (bfu*)(p.ws + S_QABS);
  const float* WK = p.in[I_WKVB] + (size_t)layer * 128 * 768;
  for (int it = tid; it < 768; it += NT) {
    const int h = it >> 7, c = it & 127;
    float wcol[64];
    _Pragma("unroll") for (int d = 0; d < 64; d += 4) { float4 v = *(const float4*)(WK + c * 768 + h * 128 + d); wcol[d] = v.x; wcol[d + 1] = v.y; wcol[d + 2] = v.z; wcol[d + 3] = v.w; }
    for (int row = 0; row < 32; ++row) {
      const bfu* q = Qs + (long)(b * 32 + row) * 576 + h * 96;
      float acc = 0.f;
      _Pragma("unroll") for (int d = 0; d < 64; ++d) acc += bf2f(q[d]) * wcol[d];
      QA[((long)(b * 6 + h) * 32 + row) * 160 + c] = f2bf(acc);
    }
  }
  for (int e = tid; e < 6 * 32 * 32; e += NT) { const int h = e >> 10, row = (e >> 5) & 31, c = e & 31;
    QA[((long)(b * 6 + h) * 32 + row) * 160 + 128 + c] = Qs[(long)(b * 32 + row) * 576 + h * 96 + 64 + c]; }
  __threadfence(); __syncthreads();
  const bfu* Kc = (const bfu*)(p.ws + S_KCAT) + (long)b * SKP * 160;
  const bfu* Vt = (const bfu*)(p.ws + S_VT) + (long)b * 128 * SKP;
  const int hw = wave < 6 ? wave : 0;
  const bfu* Q = QA + ((long)(b * 6 + hw) * 32 + ln) * 160;
  bfu* stash = (bfu*)(shm + 2 * Attn<160, 64>::BUF);
  for (int half = 0; half < 2; ++half) {
    f32x16 O[2]; float lsum;
    Attn<160, 64>::run(Kc, Vt + (long)half * 64 * SKP, SKP, 65, wave < 6 ? 65 : 0, SKS, Q, shm, O, lsum, tid);
    if (wave < 6) { const float inv = 1.f / lsum;
      _Pragma("unroll") for (int mt = 0; mt < 2; ++mt) _Pragma("unroll") for (int r = 0; r < 16; ++r)
        stash[half * 12288 + (wave * 32 + ln) * 64 + mt * 32 + crow(r, hh)] = f2bf(O[mt][r] * inv); }
    __syncthreads();
  }
  if (wave < 6) {
    const int h = wave, c = lane;
    float acc[32];
    _Pragma("unroll") for (int r = 0; r < 32; ++r) acc[r] = 0.f;
    for (int d = 0; d < 128; ++d) { const float w = WK[d * 768 + h * 128 + 64 + c];
      const bfu* o = stash + (d >> 6) * 12288 + h * 32 * 64 + (d & 63);
      _Pragma("unroll") for (int r = 0; r < 32; ++r) acc[r] += bf2f(o[r * 64]) * w; }
    bfu* MG = (bfu*)(p.ws + S_MERGED);
    _Pragma("unroll") for (int r = 0; r < 32; ++r) MG[(long)(b * 32 + r) * 1024 + h * 64 + c] = f2bf(acc[r]);
  }
  __syncthreads();
}

DI void rwkv_post(const Params& pin, int layer) {
  const Params p = relaunder(pin);
  const int tidw = ltid(p); const int wave = tidw >> 6, lane = tidw & 63, sub = lane >> 4, l16 = lane & 15;
  const long total = (long)(MP + MS) * 6;
  const float* gng = p.in[I_GNG] + layer * 384; const float* gnb = p.in[I_GNB] + layer * 384;
  for (long u0 = ((long)blockIdx.x * 8 + wave) * 16; u0 < total; u0 += (long)gridDim.x * 8 * 16) {
    uint2 yv[4], vv[4], gv[4]; float bon[4]; long mgo[4]; int cc[4]; int sm[4];
    _Pragma("unroll") for (int i = 0; i < 4; ++i) {
      const long u = u0 + i * 4 + sub;
      const int samp = u >= (long)MP * 6; const long uu = samp ? u - (long)MP * 6 : u;
      const long r = uu / 6; const int h = (int)(uu - r * 6); const int LT = samp ? 5 : 13; const int T = 1 << LT;
      const long b = r >> LT, t = r & (T - 1); const int c = h * 64 + l16 * 4;
      const bfu* Y = (const bfu*)(p.ws + (samp ? S_Y : P_Y)); const bfu* G = (const bfu*)(p.ws + (samp ? S_G : P_G));
      const float* BON = (const float*)(p.ws + (samp ? S_BON : P_BON)); const bfu* RW = (const bfu*)(p.ws + (samp ? S_RW : P_RW));
      yv[i] = *(const uint2*)(Y + r * 384 + c);
      vv[i] = *(const uint2*)(RW + ((b * 6 + h) * T + t) * 384 + 320 + l16 * 4);
      gv[i] = *(const uint2*)(G + r * 384 + c); bon[i] = BON[r * 6 + h];
      mgo[i] = r * 1024 + 640 + c; cc[i] = c; sm[i] = samp;
    }
    _Pragma("unroll") for (int i = 0; i < 4; ++i) {
      const float y0 = bf2f(yv[i].x & 0xffff), y1 = bf2f(yv[i].x >> 16), y2 = bf2f(yv[i].y & 0xffff), y3 = bf2f(yv[i].y >> 16);
      const float mu = allred16(y0 + y1 + y2 + y3) * (1.f / 64);
      const float d0 = y0 - mu, d1 = y1 - mu, d2 = y2 - mu, d3 = y3 - mu;
      const float var = allred16(d0 * d0 + d1 * d1 + d2 * d2 + d3 * d3) * (1.f / 64);
      const float rs = rsqrtf(var + 64e-5f);
      const float4 g4 = *(const float4*)(gng + cc[i]), b4 = *(const float4*)(gnb + cc[i]);
      const float v0 = bf2f(vv[i].x & 0xffff), v1 = bf2f(vv[i].x >> 16), v2 = bf2f(vv[i].y & 0xffff), v3 = bf2f(vv[i].y >> 16);
      const float q0 = bf2f(gv[i].x & 0xffff), q1 = bf2f(gv[i].x >> 16), q2 = bf2f(gv[i].y & 0xffff), q3 = bf2f(gv[i].y >> 16);
      const float o0 = (d0 * rs * g4.x + b4.x + bon[i] * v0) * q0, o1 = (d1 * rs * g4.y + b4.y + bon[i] * v1) * q1;
      const float o2 = (d2 * rs * g4.z + b4.z + bon[i] * v2) * q2, o3 = (d3 * rs * g4.w + b4.w + bon[i] * v3) * q3;
      bfu* MG = (bfu*)(p.ws + (sm[i] ? S_MERGED : P_MERGED));
      *(uint2*)(MG + mgo[i]) = make_uint2(pack2(o0, o1), pack2(o2, o3));
    }
  }
}


#define XB_TMO      128
#define XB_XCNT(j)  (256  + 64 * (j))
#define XB_XSUB(j)  (1280 + 64 * (j))
#define XB_XGEN(j)  (2304 + 64 * (j))
#define XB_TOP      3328
#define XB_TOPGEN   3392
#define XCD_BAR_WORDS 3456
#define XB_SPIN_CAP (1u << 18)
#define LAS __attribute__((address_space(3)))
constexpr size_t OFF_BAR = OFF_CTL + 655360;
DI unsigned xb_ld(unsigned* p) { return __hip_atomic_load(p, __ATOMIC_RELAXED, __HIP_MEMORY_SCOPE_AGENT); }
DI unsigned xb_add(unsigned* p, unsigned v) { return __hip_atomic_fetch_add(p, v, __ATOMIC_RELAXED, __HIP_MEMORY_SCOPE_AGENT); }
DI unsigned xb_xcc_id() { return (unsigned)__builtin_amdgcn_s_getreg((3 << 11) | 20) & 0xFu; }
#define XB_SPIN(cond, bar) do { unsigned _sp = 0; while (cond) { __builtin_amdgcn_s_sleep(1); \
    if ((++_sp & 255u) == 0u) { if (xb_ld(&(bar)[XB_TMO])) break; if (_sp > XB_SPIN_CAP) { atomicAdd(&(bar)[XB_TMO], 1u); break; } } } } while (0)
DI void xcd_barrier_complete(unsigned* bar, unsigned x, unsigned& nloc, unsigned& nx) {
  const unsigned G = gridDim.x;
  unsigned sum, cnt, mine, sp = 0u;
  for (;;) {
    sum = 0u; cnt = 0u; mine = 0u;
    _Pragma("unroll") for (unsigned j = 0; j < 16; ++j) { const unsigned c = xb_ld(&bar[XB_XCNT(j)]); sum += c; cnt += (c > 0u) ? 1u : 0u; mine = (j == x) ? c : mine; }
    if (sum == G) break;
    __builtin_amdgcn_s_sleep(1);
    if ((++sp & 255u) == 0u) { if (xb_ld(&bar[XB_TMO])) break; if (sp > XB_SPIN_CAP) { atomicAdd(&bar[XB_TMO], 1u); break; } }
  }
  nloc = mine > 0u ? mine : 1u; nx = cnt > 0u ? cnt : 1u;
}
DI void xcd_barrier(unsigned* bar, const unsigned x, char* shm, const bool leader) {
  volatile LAS unsigned* st = (volatile LAS unsigned*)(shm + SHM_MAIN + 1040);
  asm volatile("s_waitcnt vmcnt(0)" ::: "memory");
  __syncthreads();
  if (leader) {
    __builtin_amdgcn_s_waitcnt(0);
    unsigned nloc = st[0], nx = st[1];
    if (nloc == 0u) { xcd_barrier_complete(bar, x, nloc, nx); st[0] = nloc; st[1] = nx; }
    const unsigned old = xb_add(&bar[XB_XSUB(x)], 1u);
    const unsigned gen = old / nloc;
    if (old + 1u == (gen + 1u) * nloc) {
      __builtin_amdgcn_fence(__ATOMIC_RELEASE, "agent");
      asm volatile("s_waitcnt vmcnt(0)" ::: "memory");
      const unsigned og = xb_add(&bar[XB_TOP], 1u);
      const unsigned tg = og / nx;
      if (og + 1u == (tg + 1u) * nx) xb_add(&bar[XB_TOPGEN], 1u);
      else XB_SPIN(xb_ld(&bar[XB_TOPGEN]) == tg, bar);
      __builtin_amdgcn_fence(__ATOMIC_ACQUIRE, "agent");
      xb_add(&bar[XB_XGEN(x)], 1u);
      asm volatile("s_waitcnt vmcnt(0)" ::: "memory");
    } else {
      XB_SPIN(xb_ld(&bar[XB_XGEN(x)]) == gen, bar);
      __builtin_amdgcn_fence(__ATOMIC_ACQUIRE, "agent");
      asm volatile("s_waitcnt vmcnt(0)" ::: "memory");
    }
  }
  __syncthreads();
}

DI void run_phase(const Params& p, int ph, int spos, char* shm) {
  if (ph == 0) { U_INIT(phase_init(p, shm)); return; }
  const int layer = (ph - 1) / 9, sub = (ph - 1) % 9;
  const int bid = blockIdx.x, G = gridDim.x;
  int nj = 0, k0 = 0, k1 = 0, k2 = 0, s0 = 0, s1 = 1, s2 = 0, n0 = 0, n1 = 0, n2 = 0;
  if (sub == 0) { nj = 2; k0 = k1 = K_PROJ; n0 = 2048; n1 = 16; }
  else if (sub == 1) { nj = 3; k0 = k1 = K_Q; k2 = K_KV; n0 = 768; n1 = 6; n2 = 768; }
  else if (sub == 3) { nj = 2; k0 = k1 = K_GLU; n0 = 256; n1 = 2; }
  else if (sub == 4) { nj = 2; k0 = k1 = K_RES1; n0 = 1024; n1 = 32; }
  else if (sub == 6) { nj = 2; k0 = k1 = K_UP; n0 = 4096; n1 = 32; }
  else if (sub == 7) { nj = 2; k0 = k1 = K_RES2; n0 = 1024; n1 = 32; }
  if (nj > 0) {
    const int tot = n0 + n1 + n2;
    bool pre = false; Job cj = get_job(p, k0, layer, 0, 0); int cbr = 0, cbc = 0;
    auto decode = [&](int t, Job& j, int& br, int& bc) {
      int kind, samp, lt;
      if (t < n0) { kind = k0; samp = s0; lt = t; } else if (t < n0 + n1) { kind = k1; samp = s1; lt = t - n0; } else { kind = k2; samp = s2; lt = t - n0 - n1; }
      const bool spl = samp && (kind == K_RES1 || kind == K_RES2);
      j = get_job(p, kind, layer, samp, spl ? (lt >> 3) : 0);
      tile_coords(j, spl ? (lt & 7) : lt, br, bc);
    };
    if (bid < tot) decode(bid, cj, cbr, cbc);
    for (int t = bid; t < tot; t += G) {
      Job nj = cj; int nbr = 0, nbc = 0; const bool hasn = t + G < tot;
      if (hasn) decode(t + G, nj, nbr, nbc);
      U_GEMM(gemm_do_tile(p, cj, layer, cbr, cbc, pre, hasn, nj, nbr, nbc, shm));
      pre = hasn; cj = nj; cbr = nbr; cbc = nbc;
    }
  }
  if (sub == 1) {
    const int ns5 = 128, nrp = 2048, nrs = 16, nmp = 1024, nms = 8, ncc = 1024;
    const int e2 = ns5, e3 = e2 + nrp, e4 = e3 + nrs, e5 = e4 + nmp, e6 = e5 + nms, e7 = e6 + ncc;
    unsigned* pctr = (unsigned*)(p.ws + OFF_CTL) + spos * 16 + 9;
    int* su = (int*)(shm + SHM_MAIN + 1024);
    while (true) {
      if (ltid(p) == 0) *su = (int)atomicAdd(pctr, 1u);
      __syncthreads();
      const int t = *su;
      __syncthreads();
      if (t >= e7) break;
      if (t < e2) U_S5(s5_unit(p, layer, 0, t, 1, shm));
      else if (t < e4) U_RP(rwkv_prep_unit(p, layer, t >= e3, t < e3 ? t - e2 : t - e3, shm));
      else if (t < e6) mla_prep_unit(p, layer, t >= e5, t < e5 ? t - e4 : t - e5);
      else U_CC(cache_conv_unit(p, layer, t - e6, shm));
      __syncthreads();
    }
  } else if (sub == 2) {
    unsigned* ctr = (unsigned*)(p.ws + OFF_CTL) + spos * 16;
    int* su = (int*)(shm + SHM_MAIN + 1024);
    const int nspec = 96 + 128 + 16 + 192 + 32;
    const int myx = blockIdx.x & 7;
    bool spec_done = false; int xk = 0;
    while (true) {
      if (ltid(p) == 0) {
        int u = -1;
        if (!spec_done) { const int a = (int)atomicAdd(ctr, 1u); if (a < nspec) u = a; }
        if (u < 0) {
          for (int k = xk; k < 8; ++k) { const int xx = (myx + k) & 7; const int a = (int)atomicAdd(ctr + 1 + xx, 1u);
            if (a < 96) { u = nspec + xx * 96 + a; break; } }
        }
        *su = u;
      }
      __syncthreads();
      const int u = *su;
      __syncthreads();
      if (u < 0) break;
      if (u >= nspec) { spec_done = true; }
      if (u < 96 || (u >= 240 && u < 432)) U_SCAN(rwkv_scan_unit(p, layer, u >= 96, u < 96 ? u : u - 240, shm));
      else if (u < 112) U_AS(attn_sample_unit(p, layer, u - 96, shm));
      else if (u < 240 || (u >= 432 && u < nspec)) U_S5(s5_unit(p, layer, u >= 240, u < 240 ? u - 112 : u - 432, 2, shm));
      else { const int v = u - nspec, xx = v / 96, a = v % 96; const int bh = xx * 6 + a / 16, qb = 15 - (a & 15);
        U_AP(attn_prompt_unit(p, bh, qb, shm)); }
      __syncthreads();
    }
  } else if (sub == 3) {
    rwkv_post(p, layer);
  } else if (sub == 5) {
    ln_rows(p, layer, 0, 0);
  } else if (sub == 8) {
    ln_rows(p, layer, 1, layer == 1);
  }
}

#ifndef SCHED_LIST
#define SCHED_LIST 0, 1, 2, 3, 4, 5, 6, 7, 8, 9, 10, 11, 12, 13, 14, 15, 16, 17, 18
#endif
__constant__ int c_sched[] = {SCHED_LIST};
constexpr int NSCHED = sizeof((int[]){SCHED_LIST}) / sizeof(int);

__global__ void __launch_bounds__(NT) mega(Params p, int ph_lo, int ph_hi) {
  __shared__ __attribute__((aligned(16))) char shm[SHM_BYTES];
  p.wave = __builtin_amdgcn_readfirstlane((int)(threadIdx.x >> 6));
#if MULTI
  for (int i = ph_lo; i < ph_hi; ++i) run_phase(p, c_sched[i], i, shm);
#else
  cg::grid_group grid = cg::this_grid();
  unsigned* bar = (unsigned*)(p.ws + OFF_BAR);
  const bool leader = (threadIdx.x == 0);
  if (leader) { volatile LAS unsigned* st = (volatile LAS unsigned*)(shm + SHM_MAIN + 1040); st[0] = 0u; st[1] = 0u; }
  __syncthreads();
  const unsigned xcc = xb_xcc_id();
  if (leader) (void)xb_add(&bar[XB_XCNT(xcc)], 1u);
  for (int i = ph_lo; i < ph_hi; ++i) {
    run_phase(p, c_sched[i], i, shm);
    if (i + 1 < ph_hi) {
      if (i == ph_lo) grid.sync();
      else xcd_barrier(bar, xcc, shm, p.wave == 0 && lane_id() == 0);
    }
  }
#endif
}

extern "C" void kernel_launch(void* const* d_in, const int* in_sizes, int n_in, void* d_out, int out_size, void* d_ws, size_t ws_size,
                              hipStream_t stream) {
  Params p{};
  _Pragma("unroll") for (int i = 0; i < 40; ++i) p.in[i] = (const float*)d_in[i];
  p.out = (float*)d_out; p.ws = (char*)d_ws;
  if (ws_size < WS_NEED) { fprintf(stderr, "workspace too small: %zu < %zu\n", ws_size, (size_t)WS_NEED); return; }
#if MULTI
  for (int ph = 0; ph < NSCHED; ++ph) {
    hipLaunchKernelGGL(mega, dim3(256), dim3(NT), 0, stream, p, ph, ph + 1);
  }
#else
  static int grid_blocks = 0;
  if (!grid_blocks) {
    int dev = 0, cus = 0, per_cu = 0;
    hipGetDevice(&dev);
    hipDeviceGetAttribute(&cus, hipDeviceAttributeMultiprocessorCount, dev);
    hipOccupancyMaxActiveBlocksPerMultiprocessor(&per_cu, mega, NT, 0);
    if (per_cu > 1) per_cu = 1;
    grid_blocks = cus * per_cu;
  }
  int lo = 0, hi = NSCHED;
  (void)hipMemsetAsync((char*)d_ws + OFF_BAR, 0, XCD_BAR_WORDS * 4, stream);
  void* args[] = {&p, &lo, &hi};
  hipError_t e = hipLaunchCooperativeKernel((void*)mega, dim3(grid_blocks), dim3(NT), args, 0, stream);
  if (e != hipSuccess) fprintf(stderr, "cooperative launch failed: %s (grid %d)\n", hipGetErrorString(e), grid_blocks);
#endif
}
```
